# Optimizing an MI355X kernel written in HIP

```python
import jax
import jax.numpy as jnp
from jax import lax
import numpy as np

D_MODEL = 1024
BATCH = 2
SEQ = 8192
DEPTH = 1

GRID_W = 64
CTX_LEN = 256
N_HEADS = 8
QK_NOPE_DIM = 128
QK_ROPE_DIM = 64
QK_HEAD_DIM = QK_NOPE_DIM + QK_ROPE_DIM
V_HEAD_DIM = 128
Q_LORA_RANK = 384
KV_LORA_RANK = 256
CONV_DIM = D_MODEL
CONV_KSIZE = 3
D_FF = 256 * ((8 * D_MODEL + 3 * 256 - 1) // (3 * 256))
ROPE_AXIS_DIM = QK_ROPE_DIM // 2
ROPE_THETA = 10000.0
Q_BLOCK = 128
NORM_EPS = 1e-6
MOD_CHUNKS = 6
IN_SIZES = (CONV_DIM, CONV_DIM, CONV_DIM, Q_LORA_RANK, KV_LORA_RANK, QK_ROPE_DIM, D_MODEL, D_MODEL)
IN_SPLITS = tuple(int(v) for v in np.cumsum(IN_SIZES)[:-1])
D_IN = int(sum(IN_SIZES))

kernel_name = "hybrid_shortconv_mla_dit_block"


def rms_norm(t, g):
    tf = t.astype(jnp.float32)
    tf = tf * lax.rsqrt(jnp.mean(tf * tf, axis=-1, keepdims=True) + NORM_EPS)
    return (tf * g.astype(jnp.float32)).astype(t.dtype)


def modulate(t, shift, scale):
    return t * (1 + scale) + shift


def adaln_params(cond, w_mod, b_mod):
    return jnp.split(jax.nn.silu(cond) @ w_mod + b_mod, MOD_CHUNKS, axis=-1)


def axial_rope_tables(rows, dtype):
    row_pos, col_pos = jnp.meshgrid(jnp.arange(rows), jnp.arange(GRID_W), indexing="ij")
    half = ROPE_AXIS_DIM // 2
    freqs = ROPE_THETA ** (-jnp.arange(half, dtype=jnp.float32) / half)
    ang = jnp.concatenate([row_pos.reshape(-1, 1).astype(jnp.float32) * freqs,
                           col_pos.reshape(-1, 1).astype(jnp.float32) * freqs], axis=-1)
    return jnp.cos(ang).astype(dtype), jnp.sin(ang).astype(dtype)


def rope_2d(t, cos, sin):
    half = ROPE_AXIS_DIM // 2
    outs = []
    for a in range(2):
        seg = t[..., a * ROPE_AXIS_DIM:(a + 1) * ROPE_AXIS_DIM]
        ca = cos[:, a * half:(a + 1) * half]
        sa = sin[:, a * half:(a + 1) * half]
        x1, x2 = seg[..., :half], seg[..., half:]
        outs.append(x1 * ca - x2 * sa)
        outs.append(x1 * sa + x2 * ca)
    return jnp.concatenate(outs, axis=-1)


def rope_tail(t, rope):
    if rope is None:
        return t
    cos, sin = rope
    return jnp.concatenate([t[..., :QK_NOPE_DIM], rope_2d(t[..., QK_NOPE_DIM:], cos, sin)], axis=-1)


def depthwise_conv3(u, w, b):
    y = lax.conv_general_dilated(u, w[:, None, :], window_strides=(1,), padding="SAME",
                                 dimension_numbers=("NWC", "WIO", "NWC"),
                                 feature_group_count=u.shape[-1])
    return y + b


def short_conv_branch(bx, cx, xx, conv_w, conv_b, w_conv_out):
    return (bx * depthwise_conv3(cx * xx, conv_w, conv_b)) @ w_conv_out


def mla_queries(q_a, q_a_norm, w_q_b, q_norm, rope):
    b, s, _ = q_a.shape
    q = (rms_norm(q_a, q_a_norm) @ w_q_b).reshape(b, s, N_HEADS, QK_HEAD_DIM).transpose(0, 2, 1, 3)
    q = rms_norm(q, q_norm)
    return rope_tail(q, rope)


def mla_keys_values(kv_a, k_rope, kv_a_norm, w_kv_b, k_norm, rope):
    b, s, _ = kv_a.shape
    kv = (rms_norm(kv_a, kv_a_norm) @ w_kv_b).reshape(b, s, N_HEADS, QK_NOPE_DIM + V_HEAD_DIM)
    kv = kv.transpose(0, 2, 1, 3)
    k_nope, v = kv[..., :QK_NOPE_DIM], kv[..., QK_NOPE_DIM:]
    k_r = jnp.broadcast_to(k_rope[:, None], (b, N_HEADS, s, QK_ROPE_DIM))
    k = rms_norm(jnp.concatenate([k_nope, k_r], axis=-1), k_norm)
    return rope_tail(k, rope), v


def attend(q, k, v):
    s = jnp.einsum("bhqd,bhkd->bhqk", q, k).astype(jnp.float32) * (QK_HEAD_DIM ** -0.5)
    p = jax.nn.softmax(s, axis=-1).astype(v.dtype)
    return jnp.einsum("bhqk,bhkd->bhqd", p, v)


def latent_attention(q, k_lat, v_lat, k_ctx, v_ctx):
    b, h, s, dk = q.shape
    k_all = jnp.concatenate([k_ctx, k_lat], axis=2)
    v_all = jnp.concatenate([v_ctx, v_lat], axis=2)
    q_blocks = q.reshape(b, h, s // Q_BLOCK, Q_BLOCK, dk).transpose(2, 0, 1, 3, 4)
    out = lax.map(lambda qb: attend(qb, k_all, v_all), q_blocks)
    return out.transpose(1, 2, 0, 3, 4).reshape(b, h, s, V_HEAD_DIM)


def merge_heads(o):
    b, h, s, d = o.shape
    return o.transpose(0, 2, 1, 3).reshape(b, s, h * d)


def gated_merge(y_conv, attn, g_conv_pre, g_attn_pre, b_gate, w_attn_o, w_out):
    y_attn = merge_heads(attn) @ w_attn_o
    g_conv = jax.nn.sigmoid(g_conv_pre + b_gate[:D_MODEL])
    g_attn = jax.nn.sigmoid(g_attn_pre + b_gate[D_MODEL:])
    return (g_conv * y_conv + g_attn * y_attn) @ w_out


def swiglu(h, w_ffn_in, w_ffn_out):
    gate, up = jnp.split(h @ w_ffn_in, 2, axis=-1)
    return (jax.nn.silu(gate) * up) @ w_ffn_out


def setup_inputs(seed: int = 0) -> dict:
    key = jax.random.key(seed)
    ks = jax.random.split(key, 23)

    def normal(k, shape, scale):
        return jax.random.normal(k, shape, jnp.float32) * scale

    def gain(k, n):
        return 1.0 + normal(k, (DEPTH, n), 0.02)

    return {
        "x": normal(ks[0], (BATCH, SEQ, D_MODEL), 1.0),
        "c": normal(ks[1], (BATCH, D_MODEL), 1.0),
        "ctx": normal(ks[2], (BATCH, CTX_LEN, D_MODEL), 1.0),
        "c_ctx": normal(ks[3], (D_MODEL,), 1.0),
        "w_mod": normal(ks[4], (DEPTH, D_MODEL, MOD_CHUNKS * D_MODEL), 0.5 * D_MODEL ** -0.5),
        "b_mod": normal(ks[5], (DEPTH, MOD_CHUNKS * D_MODEL), 0.02),
        "norm_mix": gain(ks[6], D_MODEL),
        "norm_ffn": gain(ks[7], D_MODEL),
        "w_in": normal(ks[8], (DEPTH, D_MODEL, D_IN), D_MODEL ** -0.5),
        "b_gate": normal(ks[9], (DEPTH, 2 * D_MODEL), 0.02),
        "conv_w": normal(ks[10], (DEPTH, CONV_KSIZE, CONV_DIM), CONV_KSIZE ** -0.5),
        "conv_b": normal(ks[11], (DEPTH, CONV_DIM), 0.02),
        "w_conv_out": normal(ks[12], (DEPTH, CONV_DIM, D_MODEL), CONV_DIM ** -0.5),
        "q_a_norm": gain(ks[13], Q_LORA_RANK),
        "w_q_b": normal(ks[14], (DEPTH, Q_LORA_RANK, N_HEADS * QK_HEAD_DIM), Q_LORA_RANK ** -0.5),
        "kv_a_norm": gain(ks[15], KV_LORA_RANK),
        "w_kv_b": normal(ks[16], (DEPTH, KV_LORA_RANK, N_HEADS * (QK_NOPE_DIM + V_HEAD_DIM)), KV_LORA_RANK ** -0.5),
        "q_norm": gain(ks[17], QK_HEAD_DIM),
        "k_norm": gain(ks[18], QK_HEAD_DIM),
        "w_attn_o": normal(ks[19], (DEPTH, N_HEADS * V_HEAD_DIM, D_MODEL), (N_HEADS * V_HEAD_DIM) ** -0.5),
        "w_out": normal(ks[20], (DEPTH, D_MODEL, D_MODEL), D_MODEL ** -0.5),
        "w_ffn_in": normal(ks[21], (DEPTH, D_MODEL, 2 * D_FF), D_MODEL ** -0.5),
        "w_ffn_out": normal(ks[22], (DEPTH, D_FF, D_MODEL), D_FF ** -0.5),
    }


def reference(x, c, ctx, c_ctx, w_mod, b_mod, norm_mix, norm_ffn, w_in, b_gate, conv_w, conv_b,
              w_conv_out, q_a_norm, w_q_b, kv_a_norm, w_kv_b, q_norm, k_norm, w_attn_o, w_out,
              w_ffn_in, w_ffn_out):
    rows = x.shape[1] // GRID_W
    rope = axial_rope_tables(rows, x.dtype)
    for l in range(DEPTH):
        last = l == DEPTH - 1
        sh1, sc1, g1, sh2, sc2, g2 = [m[:, None, :] for m in adaln_params(c, w_mod[l], b_mod[l])]
        csh1, csc1, cg1, csh2, csc2, cg2 = adaln_params(c_ctx, w_mod[l], b_mod[l])

        hc = modulate(rms_norm(ctx, norm_mix[l]), csh1, csc1)
        cbx, ccx, cxx, cq_a, ckv_a, ck_rope, cgc, cga = jnp.split(hc @ w_in[l], IN_SPLITS, axis=-1)
        k_ctx, v_ctx = mla_keys_values(ckv_a, ck_rope, kv_a_norm[l], w_kv_b[l], k_norm[l], None)

        hx = modulate(rms_norm(x, norm_mix[l]), sh1, sc1)
        bx, cx, xx, q_a, kv_a, k_rope, gc, ga = jnp.split(hx @ w_in[l], IN_SPLITS, axis=-1)
        y_conv = short_conv_branch(bx, cx, xx, conv_w[l], conv_b[l], w_conv_out[l])
        q_lat = mla_queries(q_a, q_a_norm[l], w_q_b[l], q_norm[l], rope)
        k_lat, v_lat = mla_keys_values(kv_a, k_rope, kv_a_norm[l], w_kv_b[l], k_norm[l], rope)
        attn = latent_attention(q_lat, k_lat, v_lat, k_ctx, v_ctx)
        x_mid = x + g1 * gated_merge(y_conv, attn, gc, ga, b_gate[l], w_attn_o[l], w_out[l])

        hx2 = modulate(rms_norm(x_mid, norm_ffn[l]), sh2, sc2)
        x_new = x_mid + g2 * swiglu(hx2, w_ffn_in[l], w_ffn_out[l])

        if not last:
            cy_conv = short_conv_branch(cbx, ccx, cxx, conv_w[l], conv_b[l], w_conv_out[l])
            q_ctx = mla_queries(cq_a, q_a_norm[l], w_q_b[l], q_norm[l], None)
            cattn = attend(q_ctx, k_ctx, v_ctx)
            ctx_mid = ctx + cg1 * gated_merge(cy_conv, cattn, cgc, cga, b_gate[l], w_attn_o[l], w_out[l])
            hc2 = modulate(rms_norm(ctx_mid, norm_ffn[l]), csh2, csc2)
            ctx = ctx_mid + cg2 * swiglu(hc2, w_ffn_in[l], w_ffn_out[l])
        x = x_new
    return x
```

```cpp
#include <hip/hip_runtime.h>
#include <hip/hip_cooperative_groups.h>
#include <cstdio>
#include <cstdint>
namespace cg = cooperative_groups;
namespace pg8 {
#define PG8_LAS __attribute__((address_space(3)))
typedef unsigned short bf16_t;
typedef short bf16x8 __attribute__((ext_vector_type(8)));
typedef float f32x4 __attribute__((ext_vector_type(4)));
typedef unsigned u32x4 __attribute__((ext_vector_type(4)));
constexpr int BM = 256, BK = 64, HALF = 128, HTB = HALF * BK * 2  , STAGE_BYTES = 8 * HTB, NXCD = 8, WGM = 8;

__host__ __device__ __forceinline__ int lds_byte(int r, int c) { const int st = (r >> 4) * 2 + (c >> 5), rr = r & 15, cc = c & 31, ob = rr * 64 + cc * 2; return st * 1024 + (ob ^ (((ob >> 9) & 1) << 5)); }
__host__ __device__ __forceinline__ void stage_rc(int b, int& R, int& C) { const int st = b / 1024, sb = b % 1024, swz = sb ^ (((sb >> 9) & 1) << 5); R = (st >> 1) * 16 + swz / 64; C = (st & 1) * 32 + (swz % 64) / 2; }
__host__ __device__ __forceinline__ int perm32(int rho) { const int n = rho >> 4, i = rho & 15; return 8 * (i >> 2) + 4 * n + (i & 3); }

struct Unit { int pm, pn; };
struct Gemm { const bf16_t* A; const bf16_t* Bt; int M, N, K; };

struct StaticOrder {
    int nM, nN, nwg, G, c;
    __host__ __device__ void init(int M, int N, int G_, int c_) { nM = M / BM; nN = N / BM; nwg = nM * nN; G = G_; c = c_; }
    __host__ __device__ bool next(int i, Unit& u) const {
        const long L = (long)i * G + c; if (L >= nwg) return false;
        int wgid = (int)L; { const int q = nwg / NXCD, r = nwg % NXCD, xcd = wgid % NXCD, off = wgid / NXCD; wgid = (xcd < r ? xcd * (q + 1) : r * (q + 1) + (xcd - r) * q) + off; }
        const int nig = WGM * nN, gid = wgid / nig, fm = gid * WGM, gsz = (nM - fm) < WGM ? (nM - fm) : WGM;
        u.pm = fm + ((wgid % nig) % gsz); u.pn = (wgid % nig) / gsz; return true;
    }
    __device__ __forceinline__ void a_ready(const Unit&) const {}
    __device__ __forceinline__ void done(const Unit&) const {}
};
__device__ __forceinline__ unsigned cvt_pk_bf16(float lo, float hi) { unsigned r; asm volatile("v_cvt_pk_bf16_f32 %0, %1, %2" : "=v"(r) : "v"(lo), "v"(hi)); return r; }
template <class Epi, class Sched, bool ALIGN_EPI = false, bool SP2 = false>
__device__ __forceinline__ void gemm_phase(PG8_LAS unsigned char* lds, const Gemm g, const Sched& S, const Epi& E) {
    int tid_ = threadIdx.x; asm volatile("" : "+v"(tid_));
    const int tid = tid_, wid = __builtin_amdgcn_readfirstlane(tid >> 6), lane = tid & 63, wr = wid >> 2, wc = wid & 3, fr = lane & 15, fq = lane >> 4;
    const int K = g.K, nt = K / BK;
    unsigned voffA[2], voffB[2];
#pragma unroll
    for (int i = 0; i < 2; ++i) { int R, C; stage_rc(tid * 16 + i * 8192, R, C); const int Rb = Epi::PERM ? ((R & ~31) + perm32(R & 31)) : R;
        voffA[i] = (unsigned)(R * K + C) * 2u; voffB[i] = (unsigned)(Rb * K + C) * 2u; }
    const size_t kstep = (size_t)(BK * 2);
    const size_t hstep = (size_t)HALF * K * 2;
    const size_t tstep = 2 * hstep;
    const unsigned ldsw = (unsigned)wid * 1024u;
    const int aoff = lds_byte(wr * 64 + fr, fq * 8), boff = lds_byte(wc * 32 + fr, fq * 8);
#define PG8_SA(b, h) (((b) * 2 + (h)) * HTB)
#define PG8_SB(b, h) ((4 + (b) * 2 + (h)) * HTB)
#define PG8_STAGE(bufoff, gbase, voff) do { _Pragma("unroll") for (int _i = 0; _i < 2; ++_i) \
        __builtin_amdgcn_global_load_lds((const unsigned*)((const char*)(gbase) + (voff)[_i]), (PG8_LAS unsigned*)(lds + (bufoff) + ldsw + _i * 8192), 16, 0, 0); } while (0)
#define PG8_LDA(dst, b, h) do { _Pragma("unroll") for (int m = 0; m < 4; ++m) _Pragma("unroll") for (int k = 0; k < 2; ++k) dst[m][k] = *(const PG8_LAS bf16x8*)(lds + PG8_SA(b, h) + aoff + m * 2048 + k * 1024); } while (0)
#define PG8_LDB(dst, b, h) do { _Pragma("unroll") for (int n = 0; n < 2; ++n) _Pragma("unroll") for (int k = 0; k < 2; ++k) dst[n][k] = *(const PG8_LAS bf16x8*)(lds + PG8_SB(b, h) + boff + n * 2048 + k * 1024); } while (0)
#define PG8_MMA(ai, bj, At, Bt) do { __builtin_amdgcn_s_setprio(1); _Pragma("unroll") for (int m = 0; m < 4; ++m) _Pragma("unroll") for (int n = 0; n < 2; ++n) _Pragma("unroll") for (int k = 0; k < 2; ++k) \
        acc[ai][bj][m][n] = __builtin_amdgcn_mfma_f32_16x16x32_bf16(Bt[n][k], At[m][k], acc[ai][bj][m][n], 0, 0, 0); __builtin_amdgcn_s_setprio(0); } while (0)
#define PG8_WAIT_V(n) asm volatile("s_waitcnt vmcnt(" #n ")" ::: "memory")
#define PG8_WAIT_L(n) asm volatile("s_waitcnt lgkmcnt(" #n ")" ::: "memory")
#define PG8_BAR __builtin_amdgcn_s_barrier()
#define PG8_SCHED __builtin_amdgcn_sched_barrier(0)
    Unit cur, nxt; int ui = 0;
    if (!S.next(0, cur)) return;
    f32x4 acc[2][2][4][2];
#pragma unroll
    for (int a = 0; a < 2; ++a)
#pragma unroll
        for (int b = 0; b < 2; ++b)
#pragma unroll
            for (int m = 0; m < 4; ++m)
#pragma unroll
                for (int n = 0; n < 2; ++n) acc[a][b][m][n] = (f32x4){0.f, 0.f, 0.f, 0.f};
    bf16x8 At[4][2], B0[2][2], B1[2][2];
    const char* cA = (const char*)g.A + (size_t)cur.pm * tstep; const char* cB = (const char*)g.Bt + (size_t)cur.pn * tstep;
    S.a_ready(cur);
    if constexpr (SP2) {
        PG8_STAGE(PG8_SB(0, 0), cB, voffB); PG8_STAGE(PG8_SB(0, 1), cB + hstep, voffB); PG8_STAGE(PG8_SA(0, 0), cA, voffA); PG8_STAGE(PG8_SA(0, 1), cA + hstep, voffA);
        if (wr == 1) PG8_BAR;
        PG8_WAIT_V(2); PG8_BAR;
        PG8_STAGE(PG8_SB(1, 0), cB + kstep, voffB); PG8_STAGE(PG8_SA(1, 0), cA + kstep, voffA); PG8_STAGE(PG8_SB(1, 1), cB + hstep + kstep, voffB);
        PG8_WAIT_V(6); PG8_BAR;
    } else {
        PG8_STAGE(PG8_SB(0, 0), cB, voffB); PG8_STAGE(PG8_SA(0, 0), cA, voffA); PG8_STAGE(PG8_SB(0, 1), cB + hstep, voffB); PG8_STAGE(PG8_SA(0, 1), cA + hstep, voffA);
        if (wr == 1) PG8_BAR;
        PG8_WAIT_V(4); PG8_BAR;
        PG8_STAGE(PG8_SB(1, 0), cB + kstep, voffB); PG8_STAGE(PG8_SA(1, 0), cA + kstep, voffA); PG8_STAGE(PG8_SB(1, 1), cB + hstep + kstep, voffB);
        PG8_WAIT_V(6); PG8_BAR;
    }
    for (;;) {
        const bool has_next = S.next(ui + 1, nxt);
        const char* nA = has_next ? (const char*)g.A + (size_t)nxt.pm * tstep : cA; const char* nB = has_next ? (const char*)g.Bt + (size_t)nxt.pn * tstep : cB;
        for (int t = 0; t < nt; t += 2) {
            const bool last = (t == nt - 2);
            const char* a1 = cA + (size_t)(t + 1) * kstep;
            const char* a2 = last ? nA : cA + (size_t)(t + 2) * kstep; const char* b2 = last ? nB : cB + (size_t)(t + 2) * kstep;
            const char* a3 = a2 + kstep; const char* b3 = b2 + kstep;
            if (last && has_next) S.a_ready(nxt);
            if constexpr (SP2) {
            PG8_LDB(B0, 0, 0); PG8_LDB(B1, 0, 1); PG8_SCHED; PG8_LDA(At, 0, 0); PG8_STAGE(PG8_SA(1, 1), a1 + hstep, voffA);
            PG8_WAIT_V(8); PG8_WAIT_L(0); PG8_BAR; PG8_MMA(0, 0, At, B0); PG8_MMA(0, 1, At, B1); PG8_BAR; PG8_SCHED;
            PG8_LDA(At, 0, 1); PG8_STAGE(PG8_SB(0, 0), b2, voffB); PG8_STAGE(PG8_SB(0, 1), b2 + hstep, voffB); PG8_STAGE(PG8_SA(0, 0), a2, voffA);
            PG8_WAIT_V(8); PG8_WAIT_L(0); PG8_BAR; PG8_MMA(1, 0, At, B0); PG8_MMA(1, 1, At, B1); PG8_BAR; PG8_SCHED;
            PG8_LDB(B0, 1, 0); PG8_LDB(B1, 1, 1); PG8_SCHED; PG8_LDA(At, 1, 0); PG8_STAGE(PG8_SA(0, 1), a2 + hstep, voffA);
            PG8_WAIT_V(8); PG8_WAIT_L(0); PG8_BAR; PG8_MMA(0, 0, At, B0); PG8_MMA(0, 1, At, B1); PG8_BAR; PG8_SCHED;
            PG8_LDA(At, 1, 1); PG8_STAGE(PG8_SB(1, 0), b3, voffB); PG8_STAGE(PG8_SB(1, 1), b3 + hstep, voffB); PG8_STAGE(PG8_SA(1, 0), a3, voffA);
            PG8_WAIT_V(8); PG8_WAIT_L(0); PG8_BAR; PG8_MMA(1, 0, At, B0); PG8_MMA(1, 1, At, B1); PG8_BAR; PG8_SCHED;
            } else {
            PG8_LDB(B0, 0, 0); PG8_SCHED; PG8_LDA(At, 0, 0); PG8_STAGE(PG8_SA(1, 1), a1 + hstep, voffA);
            PG8_WAIT_L(8); PG8_BAR; PG8_WAIT_L(0); PG8_MMA(0, 0, At, B0); PG8_BAR; PG8_SCHED;
            PG8_LDB(B1, 0, 1); PG8_STAGE(PG8_SB(0, 0), b2, voffB);
            PG8_BAR; PG8_WAIT_L(0); PG8_MMA(0, 1, At, B1); PG8_BAR;
            PG8_LDA(At, 0, 1); PG8_STAGE(PG8_SA(0, 0), a2, voffA);
            PG8_BAR; PG8_WAIT_L(0); PG8_MMA(1, 0, At, B0); PG8_BAR; PG8_SCHED;
            PG8_STAGE(PG8_SB(0, 1), b2 + hstep, voffB);
            PG8_WAIT_V(6); PG8_BAR; PG8_MMA(1, 1, At, B1); PG8_BAR;
            PG8_LDB(B0, 1, 0); PG8_SCHED; PG8_LDA(At, 1, 0); PG8_STAGE(PG8_SA(0, 1), a2 + hstep, voffA);
            PG8_WAIT_L(8); PG8_BAR; PG8_WAIT_L(0); PG8_MMA(0, 0, At, B0); PG8_BAR; PG8_SCHED;
            PG8_LDB(B1, 1, 1); PG8_STAGE(PG8_SB(1, 0), b3, voffB);
            PG8_BAR; PG8_WAIT_L(0); PG8_MMA(0, 1, At, B1); PG8_BAR;
            PG8_LDA(At, 1, 1); PG8_STAGE(PG8_SA(1, 0), a3, voffA);
            PG8_BAR; PG8_WAIT_L(0); PG8_MMA(1, 0, At, B0); PG8_BAR; PG8_SCHED;
            PG8_STAGE(PG8_SB(1, 1), b3 + hstep, voffB);
            PG8_WAIT_V(6); PG8_BAR; PG8_MMA(1, 1, At, B1); PG8_BAR;
            }
        }
        if constexpr (ALIGN_EPI) { if (wr == 0) PG8_BAR; }
        if constexpr (!Epi::AFTER_DRAIN) { E(acc, cur, wr, wc, fr, fq); S.done(cur); }
        if (!has_next) break;
#pragma unroll
        for (int a = 0; a < 2; ++a)
#pragma unroll
            for (int b = 0; b < 2; ++b)
#pragma unroll
                for (int m = 0; m < 4; ++m)
#pragma unroll
                    for (int n = 0; n < 2; ++n) acc[a][b][m][n] = (f32x4){0.f, 0.f, 0.f, 0.f};
        cur = nxt; cA = nA; cB = nB; ++ui;
        if constexpr (ALIGN_EPI) { if (wr == 1) PG8_BAR; }
    }
    PG8_WAIT_V(0);
    if constexpr (!ALIGN_EPI) { if (wr == 0) PG8_BAR; }
    PG8_BAR;
    if constexpr (Epi::AFTER_DRAIN) { E.fused(acc, cur, wr, wc, fr, fq, lds, wid, lane); S.done(cur); }
#undef PG8_SA
#undef PG8_SB
#undef PG8_STAGE
#undef PG8_LDA
#undef PG8_LDB
#undef PG8_MMA
#undef PG8_WAIT_V
#undef PG8_WAIT_L
#undef PG8_BAR
#undef PG8_SCHED
}
}

constexpr int D = 1024, SEQ = 8192, M = 16384, CTXL = 256, MC = 512, MT = M + MC;
constexpr int NH = 8, DK = 192, DV = 128, QL = 384, KVL = 256, DIN = 5824, DINP = 5888, DFF = 2816, SKV = SEQ + CTXL;
constexpr float EPS = 1e-6f;
typedef unsigned short bf16_t;
typedef float f32x4 __attribute__((ext_vector_type(4)));
typedef unsigned u32x4 __attribute__((ext_vector_type(4)));
typedef unsigned u32x2 __attribute__((ext_vector_type(2)));
#define LAS __attribute__((address_space(3)))

constexpr size_t WS_MOD = 0;
constexpr size_t MOD_BYTES = 3 * 6144 * 4;
constexpr size_t WS_BAR = 81920, WS_ROWSS = 131072, CTL_BYTES = 131072 + 65536;
constexpr size_t WS_SHW = CTL_BYTES;
constexpr size_t WS_ROPE = WS_SHW + 65536;
constexpr size_t WS_WIN = WS_ROPE + (size_t)SEQ * 64 * 4;
constexpr size_t WS_KRB = WS_WIN;
constexpr size_t WS_KRSS = WS_KRB + (size_t)MT * 64 * 4;
constexpr size_t WS_WC = WS_WIN + (size_t)DINP * D * 2;
constexpr size_t WS_WQ = WS_WC + (size_t)D * D * 2;
constexpr size_t WS_WKV = WS_WQ + (size_t)1536 * QL * 2;
constexpr size_t WS_WA = WS_WKV + (size_t)2048 * KVL * 2;
constexpr size_t WS_WO = WS_WA + (size_t)D * D * 2;
constexpr size_t WS_WF1 = WS_WO + (size_t)D * D * 2;
constexpr size_t WS_WF2 = WS_WF1 + (size_t)2 * DFF * D * 2;
constexpr size_t WS_XN = WS_WF2 + (size_t)D * DFF * 2;
constexpr size_t WS_BX = WS_XN + (size_t)MT * D * 2;
constexpr size_t WS_QAN = WS_BX + (size_t)M * D * 2;
constexpr size_t WS_KVAN = WS_QAN + (size_t)M * QL * 2;
constexpr size_t WS_R = WS_KVAN + (size_t)MT * KVL * 2;
constexpr size_t WS_UU = WS_R;
constexpr size_t WS_QA = WS_UU + (size_t)M * D * 2;
constexpr size_t WS_KVA = WS_QA + (size_t)M * QL * 2;
constexpr size_t WS_Q = WS_R;
constexpr size_t WS_K = WS_Q + (size_t)M * 1536 * 2;
constexpr size_t WS_V = WS_K + (size_t)2 * NH * SKV * DK * 2;
constexpr size_t WS_H = WS_R;
constexpr size_t WS_END = WS_V + (size_t)2 * NH * SKV * DV * 2;
static_assert(WS_END <= 268435456ull, "d_ws map exceeds 256 MiB");
static_assert(WS_KVA + (size_t)MT * 320 * 2 <= WS_END && WS_H + (size_t)M * DFF * 2 <= WS_END, "overlay");
static_assert(WS_KRSS + (size_t)MT * 4 <= WS_WC, "KRB overlay");

constexpr int LDS_BYTES = 140 * 1024;

__device__ __forceinline__ unsigned pk2(float lo, float hi) { return pg8::cvt_pk_bf16(lo, hi); }
__device__ __forceinline__ float bflo(unsigned w) { return __uint_as_float(w << 16); }
__device__ __forceinline__ float bfhi(unsigned w) { return __uint_as_float(w & 0xffff0000u); }
__device__ __forceinline__ float bf1(bf16_t h) { return __uint_as_float(((unsigned)h) << 16); }
__device__ __forceinline__ bf16_t f2bf1(float f) { return (bf16_t)(pk2(f, f) & 0xffffu); }
__device__ __forceinline__ void unpack8(u32x4 w, float* v) {
    v[0] = bflo(w.x); v[1] = bfhi(w.x); v[2] = bflo(w.y); v[3] = bfhi(w.y); v[4] = bflo(w.z); v[5] = bfhi(w.z); v[6] = bflo(w.w); v[7] = bfhi(w.w);
}
__device__ __forceinline__ u32x4 pack8(const float* v) { u32x4 w; w.x = pk2(v[0], v[1]); w.y = pk2(v[2], v[3]); w.z = pk2(v[4], v[5]); w.w = pk2(v[6], v[7]); return w; }
__device__ __forceinline__ u32x4 pack8v(f32x4 a, f32x4 b) { u32x4 w; w.x = pk2(a[0], a[1]); w.y = pk2(a[2], a[3]); w.z = pk2(b[0], b[1]); w.w = pk2(b[2], b[3]); return w; }
__device__ __forceinline__ unsigned pk4_fp8(float a, float b, float c, float d) { int w = 0; w = __builtin_amdgcn_cvt_pk_fp8_f32(a, b, w, false); w = __builtin_amdgcn_cvt_pk_fp8_f32(c, d, w, true); return (unsigned)w; }
__device__ __forceinline__ float wave_sum(float v) {
#pragma unroll
    for (int o = 1; o < 64; o <<= 1) v += __shfl_xor(v, o);
    return v;
}
__device__ __forceinline__ float sigmoidf_(float x) { return __builtin_amdgcn_rcpf(1.f + __expf(-x)); }
__device__ __forceinline__ float siluf_(float x) { return x * sigmoidf_(x); }

template <class F> struct Epi8 {
    static constexpr bool PERM = true, AFTER_DRAIN = false;
    F f;
    __device__ __forceinline__ void operator()(const pg8::f32x4 (&acc)[2][2][4][2], const pg8::Unit& u, int wr, int wc, int fr, int fq) const {
        const int cl = wc * 32 + 8 * fq;
#pragma unroll
        for (int ai = 0; ai < 2; ++ai)
#pragma unroll
            for (int m = 0; m < 4; ++m) {
                const int row = u.pm * 256 + ai * 128 + wr * 64 + m * 16 + fr;
                f(row, u.pn, cl, acc[ai][0][m][0], acc[ai][0][m][1], acc[ai][1][m][0], acc[ai][1][m][1]);
            }
    }
};
#define ST8(p, a, b) (*(u32x4*)(p) = pack8v((a), (b)))

struct FIn {
    bf16_t *BX, *UU, *QA, *KVA, *SGC, *SGA; const float* bgate;
    __device__ __forceinline__ void operator()(int row, int pn, int cl, f32x4 a0, f32x4 a1, f32x4 b0, f32x4 b1) const {
        if (pn < 4) { if (row < M) { bf16_t* p = BX + (size_t)row * D + pn * 256 + cl; ST8(p, a0, a1); ST8(p + 128, b0, b1); } }
        else if (pn < 12) { if (row < M) { bf16_t* p = UU + (size_t)row * D + (pn - 4) * 128 + cl; ST8(p, a0 * b0, a1 * b1); } }
        else if (pn < 15) {
            const int d0 = (pn - 12) * 256 + cl, d1 = d0 + 128;
            if (d0 < 384) { if (row < M) ST8(QA + (size_t)row * QL + d0, a0, a1); } else if (d0 < 704) ST8(KVA + (size_t)row * 320 + (d0 - 384), a0, a1);
            if (d1 < 384) { if (row < M) ST8(QA + (size_t)row * QL + d1, b0, b1); } else if (d1 < 704) ST8(KVA + (size_t)row * 320 + (d1 - 384), b0, b1);
        } else if (row < M) {
            const bool isa = pn >= 19; const int col = (pn - (isa ? 19 : 15)) * 256 + cl;
            const float* bg = bgate + (isa ? D : 0) + col; bf16_t* p = (isa ? SGA : SGC) + (size_t)row * D + col;
            const f32x4 g0 = *(const f32x4*)bg, g1 = *(const f32x4*)(bg + 4), g2 = *(const f32x4*)(bg + 128), g3 = *(const f32x4*)(bg + 132);
            f32x4 s0, s1, s2, s3;
#pragma unroll
            for (int i = 0; i < 4; ++i) { s0[i] = sigmoidf_(a0[i] + g0[i]); s1[i] = sigmoidf_(a1[i] + g1[i]); s2[i] = sigmoidf_(b0[i] + g2[i]); s3[i] = sigmoidf_(b1[i] + g3[i]); }
            ST8(p, s0, s1); ST8(p + 128, s2, s3);
        }
    }
};
struct FConv {
    const bf16_t* SGC; bf16_t* Z1;
    __device__ __forceinline__ void operator()(int row, int pn, int cl, f32x4 a0, f32x4 a1, f32x4 b0, f32x4 b1) const {
        const size_t o = (size_t)row * D + pn * 256 + cl; float g[8], h[8];
        unpack8(*(const u32x4*)(SGC + o), g); unpack8(*(const u32x4*)(SGC + o + 128), h);
        float r0[8], r1[8];
#pragma unroll
        for (int i = 0; i < 4; ++i) { r0[i] = g[i] * a0[i]; r0[4 + i] = g[4 + i] * a1[i]; r1[i] = h[i] * b0[i]; r1[4 + i] = h[4 + i] * b1[i]; }
        *(u32x4*)(Z1 + o) = pack8(r0); *(u32x4*)(Z1 + o + 128) = pack8(r1);
    }
};
struct FQ {
    bf16_t* Q;
    __device__ __forceinline__ void operator()(int row, int pn, int cl, f32x4 a0, f32x4 a1, f32x4 b0, f32x4 b1) const {
        bf16_t* p = Q + (size_t)row * 1536 + pn * 256 + cl; ST8(p, a0, a1); ST8(p + 128, b0, b1);
    }
};
struct EpiK2 {
    static constexpr bool PERM = true, AFTER_DRAIN = false;
    unsigned char* K; const float *KRB, *KRSS, *knorm; LAS float* T;
    __device__ __forceinline__ void operator()(const pg8::f32x4 (&acc)[2][2][4][2], const pg8::Unit& u, int wr, int wc, int fr, int fq) const {
        int tid = threadIdx.x; asm volatile("" : "+v"(tid));
        asm volatile("" : "+v"(fr), "+v"(fq)); LAS float* S = T + 2048;
#pragma unroll
        for (int ai = 0; ai < 2; ++ai)
#pragma unroll
            for (int m = 0; m < 4; ++m)
#pragma unroll
                for (int bj = 0; bj < 2; ++bj) { const f32x4 a = acc[ai][bj][m][0], b = acc[ai][bj][m][1];
                    float ss = (a[0] * a[0] + a[1] * a[1]) + (a[2] * a[2] + a[3] * a[3]) + (b[0] * b[0] + b[1] * b[1]) + (b[2] * b[2] + b[3] * b[3]);
                    ss += __shfl_xor(ss, 16); ss += __shfl_xor(ss, 32);
                    if (fq == 0) T[((ai * 128 + wr * 64 + m * 16 + fr) * 2 + bj) * 4 + wc] = ss; }
        asm volatile("s_waitcnt lgkmcnt(0)" ::: "memory"); __builtin_amdgcn_s_barrier(); asm volatile("" ::: "memory");
        { const int grow = u.pm * 256 + (tid >> 1); const float ss = (T[tid * 4] + T[tid * 4 + 1]) + (T[tid * 4 + 2] + T[tid * 4 + 3]) + KRSS[grow];
          S[tid] = rsqrtf(ss * (1.f / DK) + EPS); }
        asm volatile("s_waitcnt lgkmcnt(0)" ::: "memory"); __builtin_amdgcn_s_barrier(); asm volatile("" ::: "memory");
        const int cl = wc * 32 + 8 * fq; const f32x4 g0 = *(const f32x4*)(knorm + cl), g1 = *(const f32x4*)(knorm + cl + 4);
#pragma unroll
        for (int ai = 0; ai < 2; ++ai)
#pragma unroll
            for (int m = 0; m < 4; ++m) { const int rl = ai * 128 + wr * 64 + m * 16 + fr, row = u.pm * 256 + rl;
                int b, pos; if (row < M) { b = row >> 13; pos = CTXL + (row & (SEQ - 1)); } else { b = (row - M) >> 8; pos = (row - M) & (CTXL - 1); }
#pragma unroll
                for (int bj = 0; bj < 2; ++bj) { const float r = S[rl * 2 + bj]; const size_t o = (size_t)(b * NH + 2 * u.pn + bj) * SKV + pos;
                    const f32x4 k0 = acc[ai][bj][m][0] * g0 * r, k1 = acc[ai][bj][m][1] * g1 * r; u32x2 w; w.x = pk4_fp8(k0[0], k0[1], k0[2], k0[3]); w.y = pk4_fp8(k1[0], k1[1], k1[2], k1[3]);
                    *(u32x2*)(K + o * DK + cl) = w; } }
        { const int rl = tid >> 1, bj = tid & 1, row = u.pm * 256 + rl; const float r = S[tid];
          int b, pos; if (row < M) { b = row >> 13; pos = CTXL + (row & (SEQ - 1)); } else { b = (row - M) >> 8; pos = (row - M) & (CTXL - 1); }
          unsigned char* p = K + ((size_t)(b * NH + 2 * u.pn + bj) * SKV + pos) * DK + 128; const float* kb = KRB + (size_t)row * 64;
#pragma unroll 1
          for (int i = 0; i < 4; ++i) { const f32x4 x0 = *(const f32x4*)(kb + 16 * i) * r, x1 = *(const f32x4*)(kb + 16 * i + 4) * r, x2 = *(const f32x4*)(kb + 16 * i + 8) * r, x3 = *(const f32x4*)(kb + 16 * i + 12) * r;
              u32x4 w; w.x = pk4_fp8(x0[0], x0[1], x0[2], x0[3]); w.y = pk4_fp8(x1[0], x1[1], x1[2], x1[3]); w.z = pk4_fp8(x2[0], x2[1], x2[2], x2[3]); w.w = pk4_fp8(x3[0], x3[1], x3[2], x3[3]);
              *(u32x4*)(p + 16 * i) = w; } }
    }
};
struct FVt {
    unsigned char* Vt;
    __device__ __forceinline__ void operator()(int row, int pn, int cl, f32x4 a0, f32x4 a1, f32x4 b0, f32x4 b1) const {
        const int h = row >> 7, c = row & 127;
#pragma unroll
        for (int bj = 0; bj < 2; ++bj) { const int t0 = pn * 256 + bj * 128 + cl;
            int b, pos; if (t0 < M) { b = t0 >> 13; pos = CTXL + (t0 & (SEQ - 1)); } else { b = (t0 - M) >> 8; pos = (t0 - M) & (CTXL - 1); }
            const f32x4 x = bj ? b0 : a0, y = bj ? b1 : a1; u32x2 w; w.x = pk4_fp8(x[0], x[1], x[2], x[3]); w.y = pk4_fp8(y[0], y[1], y[2], y[3]);
            *(u32x2*)(Vt + ((((size_t)(b * NH + h) * (SKV / 64) + (pos >> 6)) * 128 + c) << 6) + (pos & 63)) = w; }
    }
};
struct FAo {
    const bf16_t* SGA; bf16_t* Z;
    __device__ __forceinline__ void operator()(int row, int pn, int cl, f32x4 a0, f32x4 a1, f32x4 b0, f32x4 b1) const {
        const size_t o = (size_t)row * D + pn * 256 + cl; float g[8], h[8], z0[8], z1[8];
        unpack8(*(const u32x4*)(SGA + o), g); unpack8(*(const u32x4*)(SGA + o + 128), h);
        unpack8(*(const u32x4*)(Z + o), z0); unpack8(*(const u32x4*)(Z + o + 128), z1);
#pragma unroll
        for (int i = 0; i < 4; ++i) { z0[i] += g[i] * a0[i]; z0[4 + i] += g[4 + i] * a1[i]; z1[i] += h[i] * b0[i]; z1[4 + i] += h[4 + i] * b1[i]; }
        *(u32x4*)(Z + o) = pack8(z0); *(u32x4*)(Z + o + 128) = pack8(z1);
    }
};
struct FRes {
    const float* base; float* out; const float* gate;
    __device__ __forceinline__ void operator()(int row, int pn, int cl, f32x4 a0, f32x4 a1, f32x4 b0, f32x4 b1) const {
        const int col = pn * 256 + cl; const size_t o = (size_t)row * D + col; const float* g = gate + (row >> 13) * 6144 + col;
        const f32x4 x0 = *(const f32x4*)(base + o), x1 = *(const f32x4*)(base + o + 4), x2 = *(const f32x4*)(base + o + 128), x3 = *(const f32x4*)(base + o + 132);
        const f32x4 g0 = *(const f32x4*)g, g1 = *(const f32x4*)(g + 4), g2 = *(const f32x4*)(g + 128), g3 = *(const f32x4*)(g + 132);
        *(f32x4*)(out + o) = x0 + g0 * a0; *(f32x4*)(out + o + 4) = x1 + g1 * a1; *(f32x4*)(out + o + 128) = x2 + g2 * b0; *(f32x4*)(out + o + 132) = x3 + g3 * b1;
    }
};
struct FRes2 {
    const float* base; float* out; const float* mod; const float* nffn; bf16_t* HX2; float* ROWSS;
    __device__ __forceinline__ void operator()(int row, int pn, int cl, f32x4 a0, f32x4 a1, f32x4 b0, f32x4 b1) const {
        const int col = pn * 256 + cl; const size_t o = (size_t)row * D + col; const float* md = mod + (row >> 13) * 6144 + col;
        const f32x4 x0 = *(const f32x4*)(base + o), x1 = *(const f32x4*)(base + o + 4), x2 = *(const f32x4*)(base + o + 128), x3 = *(const f32x4*)(base + o + 132);
        const float* g = md + 2 * D; const f32x4 g0 = *(const f32x4*)g, g1 = *(const f32x4*)(g + 4), g2 = *(const f32x4*)(g + 128), g3 = *(const f32x4*)(g + 132);
        const f32x4 y0 = x0 + g0 * a0, y1 = x1 + g1 * a1, y2 = x2 + g2 * b0, y3 = x3 + g3 * b1;
        *(f32x4*)(out + o) = y0; *(f32x4*)(out + o + 4) = y1; *(f32x4*)(out + o + 128) = y2; *(f32x4*)(out + o + 132) = y3;
        const f32x4 q = y0 * y0 + y1 * y1 + y2 * y2 + y3 * y3; float ss = (q[0] + q[1]) + (q[2] + q[3]);
        ss += __shfl_xor(ss, 16); ss += __shfl_xor(ss, 32);
        if ((threadIdx.x & 48) == 0) unsafeAtomicAdd(ROWSS + row, ss);
        const float* sc = md + 4 * D; const float* nf = nffn + col;
        const f32x4 s0 = *(const f32x4*)sc + 1.f, s1 = *(const f32x4*)(sc + 4) + 1.f, s2 = *(const f32x4*)(sc + 128) + 1.f, s3 = *(const f32x4*)(sc + 132) + 1.f;
        const f32x4 n0 = *(const f32x4*)nf, n1 = *(const f32x4*)(nf + 4), n2 = *(const f32x4*)(nf + 128), n3 = *(const f32x4*)(nf + 132);
        ST8(HX2 + o, y0 * n0 * s0, y1 * n1 * s1); ST8(HX2 + o + 128, y2 * n2 * s2, y3 * n3 * s3);
    }
};
struct FFfn1 {
    bf16_t* H; const float* ROWSS; const float* SHW;
    __device__ __forceinline__ void operator()(int row, int pn, int cl, f32x4 a0, f32x4 a1, f32x4 b0, f32x4 b1) const {
        const float r = rsqrtf(ROWSS[row] * (1.f / D) + EPS); const float* sw = SHW + (row >> 13) * (2 * DFF) + pn * 256 + cl;
        const f32x4 c0 = *(const f32x4*)sw, c1 = *(const f32x4*)(sw + 4), c2 = *(const f32x4*)(sw + 128), c3 = *(const f32x4*)(sw + 132);
        a0 = a0 * r + c0; a1 = a1 * r + c1; b0 = b0 * r + c2; b1 = b1 * r + c3;
        f32x4 h0, h1;
#pragma unroll
        for (int i = 0; i < 4; ++i) { h0[i] = siluf_(a0[i]) * b0[i]; h1[i] = siluf_(a1[i]) * b1[i]; }
        ST8(H + (size_t)row * DFF + pn * 128 + cl, h0, h1);
    }
};

namespace att {
using bf16x8 = __attribute__((ext_vector_type(8))) short;
using s16x4 = __attribute__((ext_vector_type(4))) short;
using f32x16 = __attribute__((ext_vector_type(16))) float;
using v8i = __attribute__((ext_vector_type(8))) int;
constexpr int NW = 8, QBLK = 32, KVBLK = 64, LDQ = 1536, LDO = 1024;
constexpr float SCALE = 0.07216878364870322f;
constexpr float THR = 3.3f;
constexpr float PSHIFT = 4.f;
constexpr float QC = SCALE * 1.4426950408889634f;
constexpr float THRL = THR * 1.4426950408889634f;
constexpr int KROW = 208;
constexpr int VROW = 80;
constexpr int SHM_V = DV * VROW, SHM_K = KVBLK * KROW;
constexpr int SLOT = SHM_K + SHM_V, NSLOT = 5;
constexpr int LDS_WS = NSLOT * SLOT, LDS_ATT = LDS_WS + NW * 64 * 4;
#define SBAR() __builtin_amdgcn_sched_barrier(0)
__device__ __forceinline__ int crow(int r, int hi) { return (r & 3) + 8 * (r >> 2) + 4 * hi; }
__device__ __forceinline__ unsigned cvtpk(float lo, float hi) { unsigned r; asm volatile("v_cvt_pk_bf16_f32 %0, %1, %2" : "=v"(r) : "v"(lo), "v"(hi)); return r; }
__device__ __forceinline__ void smx(f32x16& p0, f32x16& p1, f32x16& q0, f32x16& q1, float& nm, f32x16& negm, float& alpha, float& l_reg, bool first, v8i& pf) {
    float pmax = p0[0];
#pragma unroll
    for (int r = 1; r < 16; ++r) pmax = fmaxf(pmax, p0[r]);
#pragma unroll
    for (int r = 0; r < 16; ++r) pmax = fmaxf(pmax, p1[r]);
    { auto rr = __builtin_amdgcn_permlane32_swap(__float_as_uint(pmax), __float_as_uint(pmax), false, false);
      pmax = fmaxf(__uint_as_float(rr[0]), __uint_as_float(rr[1])); }
    alpha = 1.f;
    if (__builtin_expect(first || __any(pmax > PSHIFT + THRL), 0)) {
        asm volatile("" ::: "memory");
        const float delta = first ? pmax - PSHIFT : fmaxf(pmax - PSHIFT, 0.f);
        nm -= delta; alpha = __builtin_amdgcn_exp2f(-delta);
#pragma unroll
        for (int r = 0; r < 16; ++r) { p0[r] -= delta; p1[r] -= delta; q0[r] -= delta; q1[r] -= delta; negm[r] = nm; }
        asm volatile("" : "+v"(negm));
    }
#pragma unroll
    for (int r = 0; r < 16; ++r) p0[r] = __builtin_amdgcn_exp2f(p0[r]);
#pragma unroll
    for (int r = 0; r < 16; ++r) p1[r] = __builtin_amdgcn_exp2f(p1[r]);
    float ps = 0;
#pragma unroll
    for (int r = 0; r < 16; ++r) ps += p0[r];
#pragma unroll
    for (int r = 0; r < 16; ++r) ps += p1[r];
    { auto rr = __builtin_amdgcn_permlane32_swap(__float_as_uint(ps), __float_as_uint(ps), false, false);
      ps = __uint_as_float(rr[0]) + __uint_as_float(rr[1]); }
    l_reg = l_reg * alpha + ps;
#pragma unroll
    for (int i = 0; i < 4; ++i) { pf[i] = (int)pk4_fp8(p0[4 * i], p0[4 * i + 1], p0[4 * i + 2], p0[4 * i + 3]); pf[4 + i] = (int)pk4_fp8(p1[4 * i], p1[4 * i + 1], p1[4 * i + 2], p1[4 * i + 3]); }
}
__device__ __forceinline__ void qkt(f32x16& p0, f32x16& p1, const char* Ks, const v8i* qf, const f32x16& negm, int r32, int hi) {
    p0 = negm; p1 = negm;
    const char* kp = Ks + r32 * KROW + 32 * hi;
#define KLD(s, X0, X1, Y0, Y1) const u32x4 X0 = *reinterpret_cast<const u32x4*>(kp + 64 * (s)), X1 = *reinterpret_cast<const u32x4*>(kp + 64 * (s) + 16), \
    Y0 = *reinterpret_cast<const u32x4*>(kp + 32 * KROW + 64 * (s)), Y1 = *reinterpret_cast<const u32x4*>(kp + 32 * KROW + 64 * (s) + 16)
#define KMM(s, X0, X1, Y0, Y1) do { const v8i A0 = {(int)X0.x, (int)X0.y, (int)X0.z, (int)X0.w, (int)X1.x, (int)X1.y, (int)X1.z, (int)X1.w}; \
    const v8i A1 = {(int)Y0.x, (int)Y0.y, (int)Y0.z, (int)Y0.w, (int)Y1.x, (int)Y1.y, (int)Y1.z, (int)Y1.w}; \
    p0 = __builtin_amdgcn_mfma_scale_f32_32x32x64_f8f6f4(A0, qf[s], p0, 0, 0, 0, 0, 0, 0); \
    p1 = __builtin_amdgcn_mfma_scale_f32_32x32x64_f8f6f4(A1, qf[s], p1, 0, 0, 0, 0, 0, 0); } while (0)
    KLD(0, a0, a1, a2, a3);
    KLD(1, b0, b1, b2, b3); KMM(0, a0, a1, a2, a3); __builtin_amdgcn_sched_barrier(0x40E);
    KLD(2, c0, c1, c2, c3); KMM(1, b0, b1, b2, b3);
    KMM(2, c0, c1, c2, c3);
#undef KLD
#undef KMM
}
__device__ __forceinline__ void pv_d0(f32x16* o, const char* Vs, const v8i pf, int r32, int hi) {
    const char* vp = Vs + r32 * VROW + 16 * hi;
#pragma unroll
    for (int d0 = 0; d0 < 4; ++d0) {
        const u32x4 x0 = *reinterpret_cast<const u32x4*>(vp + d0 * 32 * VROW), x1 = *reinterpret_cast<const u32x4*>(vp + d0 * 32 * VROW + 32);
        const v8i B = {(int)x0.x, (int)x0.y, (int)x0.z, (int)x0.w, (int)x1.x, (int)x1.y, (int)x1.z, (int)x1.w};
        o[d0] = __builtin_amdgcn_mfma_scale_f32_32x32x64_f8f6f4(pf, B, o[d0], 0, 0, 0, 0, 0, 0);
        if (d0 == 1) __builtin_amdgcn_sched_barrier(0x40E); }
}
__device__ __forceinline__ void attn_unit(const bf16_t* __restrict__ Qb, const unsigned char* __restrict__ Kh, const unsigned char* __restrict__ Vh, bf16_t* __restrict__ Ob, char* lds, LAS unsigned char* ldsl,
                                          const float* __restrict__ qnorm, const float* __restrict__ rope, int tl0) {
    int tid = threadIdx.x; asm volatile("" : "+v"(tid));
    const int wid = tid >> 6, lane = tid & 63, r32 = lane & 31, hi = lane >> 5;
    char* ring = lds;
    unsigned doff[3];
#pragma unroll
    for (int k = 0; k < 3; ++k) { const int ii = wid + 8 * k, p = ii * 1024 + lane * 16;
        const int row = p / KROW, col = p - row * KROW, rr = row & 31, key = (row & 32) | (((rr >> 2) & 1) << 4) | (rr & 3) | ((rr >> 3) << 2); const int dk = col < DK ? key * DK + col : 0;
        const int pv = p - SHM_K, c = pv / VROW, cv = pv - c * VROW; const int dv = cv < 64 ? c * 64 + cv : 0;
        doff[k] = (unsigned)(ii < 13 ? dk : dv); }
    unsigned dpk = doff[0] | (doff[1] << 16), dp2 = doff[2];
    asm volatile("" : "+v"(dpk), "+v"(dp2));
    float* ws = (float*)(lds + LDS_WS) + wid * 64; float* al_l = ws;
    v8i qf[3];
    {
        const bf16_t* Qr = Qb + (size_t)(wid * QBLK + r32) * LDQ + 32 * hi; float ss = 0.f;
#pragma unroll
        for (int c = 0; c < 12; ++c) { float v[8]; unpack8(*reinterpret_cast<const u32x4*>(Qr + 64 * (c >> 2) + 8 * (c & 3)), v);
#pragma unroll
            for (int i = 0; i < 8; ++i) ss += v[i] * v[i];
            if ((c & 3) == 3) asm volatile("" ::: "memory"); }
        { auto rr = __builtin_amdgcn_permlane32_swap(__float_as_uint(ss), __float_as_uint(ss), false, false); ss = __uint_as_float(rr[0]) + __uint_as_float(rr[1]); }
        const float rq = rsqrtf(ss * (1.f / DK) + EPS);
        asm volatile("" ::: "memory");
#pragma unroll
        for (int s = 0; s < 2; ++s)
#pragma unroll
            for (int c = 0; c < 4; ++c) { float v[8]; unpack8(*reinterpret_cast<const u32x4*>(Qr + 64 * s + 8 * c), v); const float* g = qnorm + 64 * s + 32 * hi + 8 * c;
#pragma unroll
                for (int i = 0; i < 8; ++i) v[i] = v[i] * (rq * QC) * g[i];
                qf[s][2 * c] = (int)pk4_fp8(v[0], v[1], v[2], v[3]); qf[s][2 * c + 1] = (int)pk4_fp8(v[4], v[5], v[6], v[7]);
                asm volatile("" ::: "memory"); }
        const float* rt = rope + (size_t)(tl0 + wid * QBLK + r32) * 64 + hi * 16; const float* g = qnorm + 128 + 32 * hi;
#pragma unroll
        for (int c = 0; c < 2; ++c) { float x1[8], x2[8], oa[8], ob[8]; unpack8(*reinterpret_cast<const u32x4*>(Qr + 128 + 8 * c), x1); unpack8(*reinterpret_cast<const u32x4*>(Qr + 144 + 8 * c), x2);
#pragma unroll
            for (int i = 0; i < 8; ++i) { const float a = x1[i] * (rq * QC) * g[8 * c + i], b = x2[i] * (rq * QC) * g[16 + 8 * c + i], cs = rt[8 * c + i], sn = rt[32 + 8 * c + i]; oa[i] = a * cs - b * sn; ob[i] = a * sn + b * cs; }
            qf[2][2 * c] = (int)pk4_fp8(oa[0], oa[1], oa[2], oa[3]); qf[2][2 * c + 1] = (int)pk4_fp8(oa[4], oa[5], oa[6], oa[7]);
            qf[2][4 + 2 * c] = (int)pk4_fp8(ob[0], ob[1], ob[2], ob[3]); qf[2][4 + 2 * c + 1] = (int)pk4_fp8(ob[4], ob[5], ob[6], ob[7]);
            asm volatile("" ::: "memory"); }
    }
    asm volatile("" : "+v"(qf[0]), "+v"(qf[1]), "+v"(qf[2]));
    float nm = 0.f, l_reg = 0.f; f32x16 o[4] = {}, negm = {};
    const int wuni = __builtin_amdgcn_readfirstlane(wid);
#define KOF(s) ((s) * SLOT)
#define VOF(s) ((s) * SLOT + SHM_K)
#define NEXT(s) ((s) == NSLOT - 1 ? 0 : (s) + 1)
#define DMA(t, s) do { const unsigned char* kt_ = Kh + (size_t)(t) * (KVBLK * DK); const unsigned char* vt_ = Vh + (size_t)(t) * (KVBLK * DV); \
    _Pragma("unroll") for (int k_ = 0; k_ < 3; ++k_) { const int ii_ = wuni + 8 * k_; if (ii_ < 23) \
        __builtin_amdgcn_global_load_lds((const unsigned*)((ii_ < 13 ? kt_ : vt_) + (k_ == 0 ? (dpk & 0xffffu) : k_ == 1 ? (dpk >> 16) : dp2)), (LAS unsigned*)(ldsl + (s) * SLOT + ii_ * 1024), 16, 0, 0); } } while (0)
#define DWAIT() asm volatile("s_waitcnt vmcnt(0)" ::: "memory")
#define RESC(a) do { if (__any((a) < 1.f)) { if (hi == 0) al_l[r32] = (a); asm volatile("s_waitcnt lgkmcnt(0)" ::: "memory"); \
    _Pragma("unroll") for (int r = 0; r < 16; ++r) { const float f_ = al_l[crow(r, hi)]; _Pragma("unroll") for (int d = 0; d < 4; ++d) o[d][r] *= f_; } } } while (0)
    f32x16 pA0, pA1, pB0, pB1; float alA; v8i pf; constexpr int NT = SKV / KVBLK;
    DMA(0, 0); DMA(1, 1); DMA(2, 2); DWAIT(); __syncthreads();
    if (wuni >= 4) __builtin_amdgcn_s_setprio(1);
    qkt(pA0, pA1, ring + KOF(0), qf, negm, r32, hi);
    int s0 = 0;
    for (int j = 0; j < NT; j += 2) {
        const int s1 = NEXT(s0), s2 = NEXT(s1), s3 = NEXT(s2), s4 = NEXT(s3);
        if (j + 3 < NT) DMA(j + 3, s3); if (j + 4 < NT) DMA(j + 4, s4);
        qkt(pB0, pB1, ring + KOF(s1), qf, negm, r32, hi);
        smx(pA0, pA1, pB0, pB1, nm, negm, alA, l_reg, j == 0, pf); RESC(alA);
        pv_d0(o, ring + VOF(s0), pf, r32, hi);
        if (j + 2 < NT) qkt(pA0, pA1, ring + KOF(s2), qf, negm, r32, hi);
        smx(pB0, pB1, pA0, pA1, nm, negm, alA, l_reg, false, pf); RESC(alA);
        pv_d0(o, ring + VOF(s1), pf, r32, hi);
        DWAIT(); __syncthreads();
        s0 = s2;
    }
    if (hi == 0) al_l[r32] = l_reg; asm volatile("s_waitcnt lgkmcnt(0)" ::: "memory");
    float rli[16];
#pragma unroll
    for (int r = 0; r < 16; ++r) rli[r] = __builtin_amdgcn_rcpf(al_l[crow(r, hi)]);
    bf16_t* Ow = Ob + (size_t)(wid * QBLK) * LDO;
#pragma unroll
    for (int r = 0; r < 16; ++r) { const int orow = crow(r, hi);
#pragma unroll
        for (int d0 = 0; d0 < 4; ++d0) Ow[(size_t)orow * LDO + d0 * 32 + r32] = f2bf1(o[d0][r] * rli[r]); }
    __builtin_amdgcn_s_setprio(0);
    __syncthreads();
#undef DMA
#undef DWAIT
#undef KOF
#undef VOF
#undef NEXT
#undef RESC
}
#undef SBAR
}
static_assert(att::LDS_ATT <= 131072, "attention LDS");

enum { MAP_ID = 0, MAP_WIN = 1, MAP_FF1 = 2, MAP_KV = 3 };
__device__ __forceinline__ int map_row(int mode, int n0) {
    if (mode == MAP_WIN) {
        if (n0 < 1024) return n0;
        if (n0 < 2048) { const int j = (n0 - 1024) >> 7, r = (n0 - 1024) & 127; return 1024 + 256 * j + r; }
        if (n0 < 3072) { const int j = (n0 - 2048) >> 7, r = (n0 - 2048) & 127; return 1024 + 256 * j + 128 + r; }
        if (n0 < 3776) return n0;
        return n0 + 64;
    } else if (mode == MAP_KV) {
        const int h = n0 >> 8, j = n0 & 255; return j < 128 ? h * 128 + j : 1024 + h * 128 + (j - 128);
    } else if (mode == MAP_FF1) {
        if (n0 < DFF) { const int j = n0 >> 7, r = n0 & 127; return 256 * j + r; }
        const int n1 = n0 - DFF, j = n1 >> 7, r = n1 & 127; return 256 * j + 128 + r;
    }
    return n0;
}
__device__ __forceinline__ void transpose_item(const float* W, int K, int N, bf16_t* WT, int mode, LAS float* scr, int item, int lane) {
    const int nblk = N / 32, kb = item / nblk, nb = item % nblk, k0 = 64 * kb, n0 = 32 * nb;
    float t_[32];
#pragma unroll
    for (int i = 0; i < 32; ++i) t_[i] = W[(size_t)(k0 + 2 * i + (lane >> 5)) * N + n0 + (lane & 31)];
#pragma unroll
    for (int i = 0; i < 32; ++i) scr[(2 * i + (lane >> 5)) * 33 + (lane & 31)] = t_[i];
    asm volatile("s_waitcnt lgkmcnt(0)" ::: "memory");
    const int c = lane & 7, dr0 = map_row(mode, n0);
#pragma unroll
    for (int j = 0; j < 4; ++j) { const int n = (lane >> 3) + 8 * j; const LAS float* s = scr + (8 * c) * 33 + n;
        u32x4 o; o.x = pk2(s[0 * 33], s[1 * 33]); o.y = pk2(s[2 * 33], s[3 * 33]); o.z = pk2(s[4 * 33], s[5 * 33]); o.w = pk2(s[6 * 33], s[7 * 33]);
        *(u32x4*)(WT + (size_t)(dr0 + n) * K + k0 + 8 * c) = o; }
    asm volatile("s_waitcnt lgkmcnt(0)" ::: "memory");
}
__device__ __forceinline__ void norm_mod_row(const float* __restrict__ xrow, const float* __restrict__ gain, const float* __restrict__ shift, const float* __restrict__ scale, bf16_t* __restrict__ orow, int lane) {
    const f32x4* xr = (const f32x4*)xrow + lane; f32x4 v[4]; float s = 0.f;
#pragma unroll
    for (int j = 0; j < 4; ++j) { v[j] = xr[64 * j]; s += (v[j].x * v[j].x + v[j].y * v[j].y) + (v[j].z * v[j].z + v[j].w * v[j].w); }
    const float r = rsqrtf(wave_sum(s) * (1.f / D) + EPS);
    u32x2* o8 = (u32x2*)orow + lane;
#pragma unroll
    for (int j = 0; j < 4; ++j) { const int c = 4 * lane + 256 * j;
        const f32x4 g = *(const f32x4*)(gain + c), sc = *(const f32x4*)(scale + c), sh = *(const f32x4*)(shift + c);
        const f32x4 y = (v[j] * r) * g * (sc + 1.f) + sh; u32x2 w; w.x = pk2(y.x, y.y); w.y = pk2(y.z, y.w); o8[64 * j] = w; }
}
__device__ __forceinline__ void rope_cs(int tl, int lane, float& c, float& s) {
    const float fr = exp2f(-(float)(lane & 15) * (13.287712379549449f / 16.f));
    const float pos = (float)((lane >> 5) ? (tl & 63) : (tl >> 6));
    sincosf(pos * fr, &s, &c);
}
__device__ __forceinline__ float rope_apply(float w, float c, float s, int lane) {
    const float p = __shfl_xor(w, 16);
    return (lane & 16) ? (p * s + w * c) : (w * c - p * s);
}

#define XB_TMO      128
#define XB_XCNT(j)  (256  + 64 * (j))
#define XB_XSUB(j)  (1280 + 64 * (j))
#define XB_XGEN(j)  (2304 + 64 * (j))
#define XB_TOP      3328
#define XB_TOPGEN   3392
#define XCD_BAR_WORDS 3456
#define XB_SPIN_CAP (1u << 18)

__device__ __forceinline__ unsigned xb_ld(unsigned* p)              { return __hip_atomic_load(p, __ATOMIC_RELAXED, __HIP_MEMORY_SCOPE_AGENT); }
__device__ __forceinline__ unsigned xb_add(unsigned* p, unsigned v) { return __hip_atomic_fetch_add(p, v, __ATOMIC_RELAXED, __HIP_MEMORY_SCOPE_AGENT); }
__device__ __forceinline__ unsigned xb_xcc_id() { return (unsigned)__builtin_amdgcn_s_getreg((3 << 11) | 20) & 0xFu; }
#define XB_SPIN(cond, bar) do { unsigned _sp = 0; while (cond) { __builtin_amdgcn_s_sleep(1); \
    if ((++_sp & 255u) == 0u) { if (xb_ld(&(bar)[XB_TMO])) break; if (_sp > XB_SPIN_CAP) { atomicAdd(&(bar)[XB_TMO], 1u); break; } } } } while (0)

struct XcdBarrier {
    unsigned* bar; unsigned x;
    volatile LAS unsigned* st;
};

__device__ __forceinline__ XcdBarrier xcd_barrier_post(unsigned* bar, volatile LAS unsigned* st) {
    XcdBarrier b; b.bar = bar; b.x = xb_xcc_id(); b.st = st;
    if (threadIdx.x == 0) (void)xb_add(&bar[XB_XCNT(b.x)], 1u);
    return b;
}
__device__ __forceinline__ void xcd_barrier_complete(unsigned* bar, unsigned x, unsigned& nloc, unsigned& nx) {
    const unsigned G = gridDim.x * gridDim.y * gridDim.z;
    unsigned sum, cnt, mine, sp = 0u;
    for (;;) {
        sum = 0u; cnt = 0u; mine = 0u;
#pragma unroll
        for (unsigned j = 0; j < 16; ++j) { const unsigned c = xb_ld(&bar[XB_XCNT(j)]); sum += c; cnt += (c > 0u) ? 1u : 0u; mine = (j == x) ? c : mine; }
        if (sum == G) break;
        __builtin_amdgcn_s_sleep(1);
        if ((++sp & 255u) == 0u) { if (xb_ld(&bar[XB_TMO])) break; if (sp > XB_SPIN_CAP) { atomicAdd(&bar[XB_TMO], 1u); break; } }
    }
    nloc = mine > 0u ? mine : 1u; nx = cnt > 0u ? cnt : 1u;
}

__device__ __forceinline__ void xcd_barrier(const XcdBarrier& b) {
    asm volatile("s_waitcnt vmcnt(0)" ::: "memory");
    __syncthreads();
    if (threadIdx.x == 0) {
        unsigned* bar = b.bar;
        __builtin_amdgcn_s_waitcnt(0);
        unsigned nloc = b.st[0], nx = b.st[1];
        if (nloc == 0u) { xcd_barrier_complete(bar, b.x, nloc, nx); b.st[0] = nloc; b.st[1] = nx; }
        const unsigned old = xb_add(&bar[XB_XSUB(b.x)], 1u);
        const unsigned gen = old / nloc;
        if (old + 1u == (gen + 1u) * nloc) {
            __builtin_amdgcn_fence(__ATOMIC_RELEASE, "agent");
            asm volatile("s_waitcnt vmcnt(0)" ::: "memory");
            const unsigned og = xb_add(&bar[XB_TOP], 1u);
            const unsigned tg = og / nx;
            if (og + 1u == (tg + 1u) * nx) xb_add(&bar[XB_TOPGEN], 1u);
            else XB_SPIN(xb_ld(&bar[XB_TOPGEN]) == tg, bar);
            __builtin_amdgcn_fence(__ATOMIC_ACQUIRE, "agent");
            asm volatile("s_waitcnt vmcnt(0)" ::: "memory");
        } else {
            XB_SPIN(xb_ld(&bar[XB_TOPGEN]) == gen, bar);
            __builtin_amdgcn_fence(__ATOMIC_ACQUIRE, "agent");
            asm volatile("s_waitcnt vmcnt(0)" ::: "memory");
        }
    }
    __syncthreads();
}

__device__ __forceinline__ void xcd_barrier_arrive(const XcdBarrier& b) {
    asm volatile("s_waitcnt vmcnt(0)" ::: "memory");
    __syncthreads();
    if (threadIdx.x == 0) {
        unsigned* bar = b.bar;
        __builtin_amdgcn_s_waitcnt(0);
        unsigned nloc = b.st[0], nx = b.st[1];
        if (nloc == 0u) { xcd_barrier_complete(bar, b.x, nloc, nx); b.st[0] = nloc; b.st[1] = nx; }
        const unsigned old = xb_add(&bar[XB_XSUB(b.x)], 1u);
        const unsigned gen = old / nloc;
        b.st[2] = gen;
        if (old + 1u == (gen + 1u) * nloc) {
            __builtin_amdgcn_fence(__ATOMIC_RELEASE, "agent");
            asm volatile("s_waitcnt vmcnt(0)" ::: "memory");
            const unsigned og = xb_add(&bar[XB_TOP], 1u);
            const unsigned tg = og / nx;
            if (og + 1u == (tg + 1u) * nx) xb_add(&bar[XB_TOPGEN], 1u);
        }
    }
}
__device__ __forceinline__ void xcd_barrier_wait(const XcdBarrier& b) {
    if (threadIdx.x == 0) {
        unsigned* bar = b.bar; const unsigned gen = b.st[2];
        XB_SPIN(xb_ld(&bar[XB_TOPGEN]) == gen, bar);
        __builtin_amdgcn_fence(__ATOMIC_ACQUIRE, "agent");
        asm volatile("s_waitcnt vmcnt(0)" ::: "memory");
    }
    __syncthreads();
}

struct Args { const float* in[23]; float* out; unsigned char* ws; int lo, hi; };
constexpr int NPHASE = 12;

__global__ void __launch_bounds__(512, 2) mega_fwd(Args args) {
    extern __shared__ __attribute__((aligned(16))) unsigned char lds[];
    cg::grid_group grid = cg::this_grid();
    const int tid = threadIdx.x, lane = tid & 63, wave = __builtin_amdgcn_readfirstlane(tid >> 6);
    const int G = gridDim.x, bx = blockIdx.x, vcu = (G % 8 == 0) ? (bx % 8) * (G / 8) + bx / 8 : bx;
    const int gw = vcu * 8 + wave, NGW = G * 8, gwb = __builtin_amdgcn_readfirstlane(wave * G + vcu);
    unsigned char* ws = args.ws;
    const float *x = args.in[0], *cnd = args.in[1], *ctx = args.in[2], *cctx = args.in[3], *w_mod = args.in[4], *b_mod = args.in[5], *norm_mix = args.in[6], *norm_ffn = args.in[7],
                *w_in = args.in[8], *b_gate = args.in[9], *conv_w = args.in[10], *conv_b = args.in[11], *w_conv_out = args.in[12], *q_a_norm = args.in[13], *w_q_b = args.in[14],
                *kv_a_norm = args.in[15], *w_kv_b = args.in[16], *q_norm = args.in[17], *k_norm = args.in[18], *w_attn_o = args.in[19], *w_out = args.in[20], *w_ffn_in = args.in[21], *w_ffn_out = args.in[22];
    float* MOD = (float*)(ws + WS_MOD);
    bf16_t *WIN = (bf16_t*)(ws + WS_WIN), *WC = (bf16_t*)(ws + WS_WC), *WQ = (bf16_t*)(ws + WS_WQ), *WKV = (bf16_t*)(ws + WS_WKV), *WA = (bf16_t*)(ws + WS_WA), *WO = (bf16_t*)(ws + WS_WO),
           *WF1 = (bf16_t*)(ws + WS_WF1), *WF2 = (bf16_t*)(ws + WS_WF2);
    bf16_t *XN = (bf16_t*)(ws + WS_XN), *BX = (bf16_t*)(ws + WS_BX), *QAN = (bf16_t*)(ws + WS_QAN), *KVAN = (bf16_t*)(ws + WS_KVAN), *UU = (bf16_t*)(ws + WS_UU), *QA = (bf16_t*)(ws + WS_QA),
           *KVA = (bf16_t*)(ws + WS_KVA), *Qb = (bf16_t*)(ws + WS_Q), *Hb = (bf16_t*)(ws + WS_H);
    unsigned char* Kb = ws + WS_K;
    unsigned char* Vtb = ws + WS_V;
    float *KRB = (float*)(ws + WS_KRB), *KRSS = (float*)(ws + WS_KRSS), *ROWSS = (float*)(ws + WS_ROWSS), *SHW = (float*)(ws + WS_SHW), *ROPE = (float*)(ws + WS_ROPE);
    bf16_t *SGC = (bf16_t*)args.out, *SGA = (bf16_t*)args.out + (size_t)M * D;
    bf16_t *U = XN, *Ob = XN, *HX2 = XN, *Z = BX;
    const int lo = args.lo, hi = args.hi;
#ifndef PH_MASK
#define PH_MASK 0x7FFF
#endif
#define IN(k) (((PH_MASK >> (k)) & 1) && lo <= (k) && (k) < hi)
#ifndef DUP_MASK
#define DUP_MASK 0
#endif
#define REP(k) for (int rep_ = 0; rep_ < (((DUP_MASK >> (k)) & 1) ? 2 : 1); ++rep_)
#ifndef MK_CG_SEAM0
#define MK_CG_SEAM0 0
#endif
#define SEAM2(k, k2) do { if (IN(k) && IN(k2)) xcd_barrier(xbar); } while (0)
#define SEAM(k) do { if (IN(k) && IN((k) + 1)) { if ((k) == 0 && MK_CG_SEAM0) grid.sync(); else xcd_barrier(xbar); } } while (0)
    LAS unsigned char* ldsl = (LAS unsigned char*)lds;
    constexpr int CI_C = 16 * 32, CI_Q = (QL / 64) * (1536 / 32), CI_KV = (KVL / 64) * (2048 / 32), CI_F1 = 16 * (2 * DFF / 32), CI_F2 = (DFF / 64) * 32;
    constexpr int CO_Q = CI_C, CO_KV = CO_Q + CI_Q, CO_A = CO_KV + CI_KV, CO_O = CO_A + CI_C, CO_F1 = CO_O + CI_C, CO_F2 = CO_F1 + CI_F1, CO_END = CO_F2 + CI_F2;
#define CONV(lo_, hi_) do { LAS float* scr_ = (LAS float*)(ldsl + wave * 16384); for (int it_ = (lo_) + gwb; it_ < (hi_); it_ += NGW) {     \
        if (it_ < CO_Q) transpose_item(w_conv_out, D, D, WC, MAP_ID, scr_, it_, lane); \
        else if (it_ < CO_KV) transpose_item(w_q_b, QL, 1536, WQ, MAP_ID, scr_, it_ - CO_Q, lane); \
        else if (it_ < CO_A) transpose_item(w_kv_b, KVL, 2048, WKV, MAP_KV, scr_, it_ - CO_KV, lane); \
        else if (it_ < CO_O) transpose_item(w_attn_o, D, D, WA, MAP_ID, scr_, it_ - CO_A, lane); \
        else if (it_ < CO_F1) transpose_item(w_out, D, D, WO, MAP_ID, scr_, it_ - CO_O, lane); \
        else if (it_ < CO_F2) transpose_item(w_ffn_in, D, 2 * DFF, WF1, MAP_FF1, scr_, it_ - CO_F1, lane); \
        else transpose_item(w_ffn_out, DFF, D, WF2, MAP_ID, scr_, it_ - CO_F2, lane); } } while (0)
#define SEAMW(work_) do { xcd_barrier_arrive(xbar); work_; xcd_barrier_wait(xbar); } while (0)
    volatile LAS unsigned* xst = (volatile LAS unsigned*)(ldsl + LDS_BYTES - 64);
    if (tid < 2) xst[tid] = 0u;
    __syncthreads();
    XcdBarrier xbar = xcd_barrier_post((unsigned*)(ws + WS_BAR), xst);
    if (args.ws == nullptr) grid.sync();

#ifdef EXTRA_SYNCS
    for (int i_ = 0; i_ < EXTRA_SYNCS; ++i_) grid.sync();
#endif
    if (IN(0)) {
        for (int cb = bx; cb < 256; cb += G) {
            LAS float* red = (LAS float*)ldsl;
            if (tid < 510) { const int q = tid % 6, ks = tid / 6; const float* wp = w_mod + cb * 24 + q * 4;
                f32x4 a0 = {0.f, 0.f, 0.f, 0.f}, a1 = a0, a2 = a0;
#pragma unroll 13
                for (int k = ks; k < D; k += 85) { const f32x4 w = *(const f32x4*)(wp + (size_t)k * 6144);
                    const float s0 = siluf_(cnd[k]), s1 = siluf_(cnd[D + k]), s2 = siluf_(cctx[k]); a0 += w * s0; a1 += w * s1; a2 += w * s2; }
#pragma unroll
                for (int i = 0; i < 4; ++i) { red[tid * 12 + i] = a0[i]; red[tid * 12 + 4 + i] = a1[i]; red[tid * 12 + 8 + i] = a2[i]; } }
            __syncthreads();
            if (tid < 72) { const int cond = tid / 24, c = tid % 24, q = c >> 2, e = c & 3; float sacc = 0.f;
                for (int ks = 0; ks < 85; ++ks) sacc += red[(ks * 6 + q) * 12 + cond * 4 + e];
                MOD[cond * 6144 + cb * 24 + c] = sacc + b_mod[cb * 24 + c]; }
            __syncthreads();
        }
        xcd_barrier_arrive(xbar);
        LAS float* scr = (LAS float*)(ldsl + wave * 16384);
        constexpr int I_IN = 16 * (DIN / 32), I_C = 16 * 32, I_Q = (QL / 64) * (1536 / 32), I_KV = (KVL / 64) * (2048 / 32), I_F1 = 16 * (2 * DFF / 32), I_F2 = (DFF / 64) * 32;
        for (int it = gw; it < I_IN; it += NGW) transpose_item(w_in, D, DIN, WIN, MAP_WIN, scr, it, lane);
        (void)I_C; (void)I_Q; (void)I_KV; (void)I_F1; (void)I_F2;
        for (int i = bx * 512 + tid; i < 64 * D / 8; i += G * 512) *(u32x4*)(WIN + (size_t)3776 * D + (size_t)i * 8) = (u32x4){0u, 0u, 0u, 0u};
    }
    xcd_barrier_wait(xbar);
    if (IN(1)) REP(1) {
#pragma unroll 2
        for (int row = gw; row < MT; row += NGW) {
            const float* src = row < M ? x + (size_t)row * D : ctx + (size_t)(row - M) * D;
            const float* md = MOD + (row < M ? (row >> 13) : 2) * 6144;
            norm_mod_row(src, norm_mix, md, md + D, XN + (size_t)row * D, lane);
        }
        xcd_barrier_arrive(xbar);
        CONV(0, CO_A);
        for (int t = gw; t < SEQ; t += NGW) {
            const int jj = lane & 31; const float fr = exp2f(-(float)(jj & 15) * (13.287712379549449f / 16.f)); const float pos = (float)((jj >> 4) ? (t & 63) : (t >> 6));
            float sn, cs; sincosf(pos * fr, &sn, &cs); ROPE[(size_t)t * 64 + lane] = lane < 32 ? cs : sn; }
    }
    xcd_barrier_wait(xbar);
    if (IN(2)) REP(2) {
        pg8::Gemm g{XN, WIN, MT, DINP, D}; pg8::StaticOrder S; S.init(MT, DINP, G, bx);
        Epi8<FIn> E{{BX, UU, QA, KVA, SGC, SGA, b_gate}};
        pg8::gemm_phase<Epi8<FIn>, pg8::StaticOrder, true, true>(ldsl, g, S, E);
    }
    SEAMW(CONV(CO_A, CO_F1));
    if (IN(3)) REP(3) {
        for (int row = gw; row < MT; row += NGW) {
            const int tl = row & (SEQ - 1); const bool lat = row < M;
            const size_t o0 = (size_t)row * D + lane * 8, o1 = o0 + 512; const u32x4 z4 = {0u, 0u, 0u, 0u};
            u32x4 lb0 = z4, lb1 = z4, lu0 = z4, lu1 = z4, lm0 = z4, lm1 = z4, lp0 = z4, lp1 = z4, lq = z4, lk = z4;
            if (lat) { lb0 = *(const u32x4*)(BX + o0); lb1 = *(const u32x4*)(BX + o1); lu0 = *(const u32x4*)(UU + o0); lu1 = *(const u32x4*)(UU + o1);
                if (tl > 0) { lm0 = *(const u32x4*)(UU + o0 - D); lm1 = *(const u32x4*)(UU + o1 - D); }
                if (tl < SEQ - 1) { lp0 = *(const u32x4*)(UU + o0 + D); lp1 = *(const u32x4*)(UU + o1 + D); }
                if (lane < 48) lq = *(const u32x4*)(QA + (size_t)row * QL + lane * 8); }
            if (lane < 32) lk = *(const u32x4*)(KVA + (size_t)row * 320 + lane * 8);
            const float kr = bf1(KVA[(size_t)row * 320 + 256 + lane]);
            float rc = 1.f, rs = 0.f; if (lat) { const float* rt = ROPE + (size_t)tl * 64 + (lane >> 5) * 16 + (lane & 15); rc = rt[0]; rs = rt[32]; }
            if (lat) {
#pragma unroll
                for (int j = 0; j < 2; ++j) { const int c = lane * 8 + 512 * j;
                    float bb[8], um[8], u0[8], up[8], r[8];
                    unpack8(j ? lb1 : lb0, bb); unpack8(j ? lu1 : lu0, u0); unpack8(j ? lm1 : lm0, um); unpack8(j ? lp1 : lp0, up);
#pragma unroll
                    for (int i = 0; i < 8; ++i) r[i] = bb[i] * (conv_w[c + i] * um[i] + conv_w[D + c + i] * u0[i] + conv_w[2 * D + c + i] * up[i] + conv_b[c + i]);
                    *(u32x4*)(U + (j ? o1 : o0)) = pack8(r); }
                float q[8]; float ss = 0.f; unpack8(lq, q);
#pragma unroll
                for (int i = 0; i < 8; ++i) ss += q[i] * q[i];
                const float rq = rsqrtf(wave_sum(ss) * (1.f / QL) + EPS);
                if (lane < 48) {
#pragma unroll
                    for (int i = 0; i < 8; ++i) q[i] = q[i] * rq * q_a_norm[lane * 8 + i];
                    *(u32x4*)(QAN + (size_t)row * QL + lane * 8) = pack8(q); }
            }
            { float q[8]; float ss = 0.f; unpack8(lk, q);
#pragma unroll
              for (int i = 0; i < 8; ++i) ss += q[i] * q[i];
              const float rk = rsqrtf(wave_sum(ss) * (1.f / KVL) + EPS);
              if (lane < 32) {
#pragma unroll
                  for (int i = 0; i < 8; ++i) q[i] = q[i] * rk * kv_a_norm[lane * 8 + i];
                  *(u32x4*)(KVAN + (size_t)row * KVL + lane * 8) = pack8(q); } }
            { const float krss = wave_sum(kr * kr); float w = kr * k_norm[128 + lane];
              if (lat) w = rope_apply(w, rc, rs, lane);
              KRB[(size_t)row * 64 + lane] = w; if (lane == 0) KRSS[row] = krss; }
        }
    }
    SEAMW(CONV(CO_F1, CO_F1 + CI_F1 / 2));
    if (IN(4)) REP(4) {
        if ((PH_MASK >> 12) & 1) { pg8::Gemm g{U, WC, M, D, D}; pg8::StaticOrder S; S.init(M, D, G, bx); Epi8<FConv> E{{SGC, Z}};
          pg8::gemm_phase<Epi8<FConv>, pg8::StaticOrder, true, true>(ldsl, g, S, E); }
        if ((PH_MASK >> 13) & 1) { int kq = QL; asm volatile("" : "+s"(kq)); pg8::Gemm g{QAN, WQ, M, 1536, kq}; pg8::StaticOrder S; S.init(M, 1536, G, bx); Epi8<FQ> E{{Qb}};
          pg8::gemm_phase<Epi8<FQ>, pg8::StaticOrder, true, true>(ldsl, g, S, E); }
        if ((PH_MASK >> 14) & 1) { int kkv = KVL; asm volatile("" : "+s"(kkv)); pg8::Gemm g{KVAN, WKV, MT, D, kkv}; pg8::StaticOrder S; S.init(MT, D, G, (bx + G / 2) % G); EpiK2 E{Kb, KRB, KRSS, k_norm, (LAS float*)(ldsl + 131072 + 1024)};
          pg8::gemm_phase<EpiK2, pg8::StaticOrder, true, true>(ldsl, g, S, E); }
        if ((PH_MASK >> 14) & 1) { int kkv = KVL; asm volatile("" : "+s"(kkv)); pg8::Gemm g{WKV + (size_t)D * KVL, KVAN, D, MT, kkv}; pg8::StaticOrder S; S.init(D, MT, G, (bx + G / 4) % G); Epi8<FVt> E{{Vtb}};
          pg8::gemm_phase<Epi8<FVt>, pg8::StaticOrder, true, true>(ldsl, g, S, E); }
    }
    SEAMW(CONV(CO_F1 + CI_F1 / 2, CO_F2));
    if (IN(6)) REP(6) {
        for (int L = vcu; L < 2 * NH * (SEQ / 256); L += G) {
            const int bh = L >> 5, qb = L & 31, b = bh >> 3, h = bh & 7;
            att::attn_unit(Qb + ((size_t)b * SEQ + qb * 256) * 1536 + h * DK, Kb + (size_t)bh * SKV * DK, Vtb + (size_t)bh * SKV * DV,
                           Ob + ((size_t)b * SEQ + qb * 256) * D + h * DV, (char*)lds, ldsl, q_norm, ROPE, qb * 256);
        }
    }
    SEAMW(CONV(CO_F2, CO_END));
    if (IN(7)) {
        pg8::Gemm g{Ob, WA, M, D, D}; pg8::StaticOrder S; S.init(M, D, G, bx); Epi8<FAo> E{{SGA, Z}};
        pg8::gemm_phase<Epi8<FAo>, pg8::StaticOrder, true, true>(ldsl, g, S, E);
    }
    xcd_barrier_arrive(xbar);
    {
        for (int n = gw; n < 2 * DFF; n += NGW) {
            float w0[8], w1[8]; unpack8(*(const u32x4*)(WF1 + (size_t)n * D + lane * 8), w0); unpack8(*(const u32x4*)(WF1 + (size_t)n * D + 512 + lane * 8), w1);
            const float* s0 = MOD + 3 * D + lane * 8; const float* s1 = s0 + 6144; float d0 = 0.f, d1 = 0.f;
#pragma unroll
            for (int i = 0; i < 8; ++i) { d0 += w0[i] * s0[i] + w1[i] * s0[512 + i]; d1 += w0[i] * s1[i] + w1[i] * s1[512 + i]; }
            d0 = wave_sum(d0); d1 = wave_sum(d1); if (lane == 0) { SHW[n] = d0; SHW[2 * DFF + n] = d1; } }
    }
    xcd_barrier_wait(xbar);
    if (IN(8)) {
        pg8::Gemm g{Z, WO, M, D, D}; pg8::StaticOrder S; S.init(M, D, G, bx); Epi8<FRes2> E{{x, args.out, MOD, norm_ffn, HX2, ROWSS}};
        pg8::gemm_phase<Epi8<FRes2>, pg8::StaticOrder, true, true>(ldsl, g, S, E);
    }
    SEAM2(8, 10);
    if (IN(10)) REP(10) {
        pg8::Gemm g{HX2, WF1, M, 2 * DFF, D}; pg8::StaticOrder S; S.init(M, 2 * DFF, G, bx); Epi8<FFfn1> E{{Hb, ROWSS, SHW}};
        pg8::gemm_phase<Epi8<FFfn1>, pg8::StaticOrder, true, true>(ldsl, g, S, E);
    }
    SEAM(10);
    if (IN(11)) {
        pg8::Gemm g{Hb, WF2, M, D, DFF}; pg8::StaticOrder S; S.init(M, D, G, bx); Epi8<FRes> E{{args.out, args.out, MOD + 5 * D}};
        pg8::gemm_phase<Epi8<FRes>, pg8::StaticOrder, true, true>(ldsl, g, S, E);
    }
#undef IN
#undef SEAM
#undef SEAM2
}

#ifndef MK_PER_PHASE
#define MK_PER_PHASE 0
#endif
extern "C" void kernel_launch(void* const* d_in, const int* in_sizes, int n_in, void* d_out, int out_size, void* d_ws, size_t ws_size, hipStream_t stream) {
    static int grid = 0;
    if (grid == 0) {
        if (n_in != 23 || out_size != M * D || ws_size < WS_END) { fprintf(stderr, "kernel_launch: unexpected shapes n_in %d out %d ws %zu (need %zu)\n", n_in, out_size, ws_size, (size_t)WS_END); grid = -1; return; }
        int dev = 0, cus = 0, per_cu = 0;
        hipGetDevice(&dev); hipDeviceGetAttribute(&cus, hipDeviceAttributeMultiprocessorCount, dev);
        if (hipFuncSetAttribute((const void*)mega_fwd, hipFuncAttributeMaxDynamicSharedMemorySize, LDS_BYTES) != hipSuccess) { fprintf(stderr, "kernel_launch: hipFuncSetAttribute failed\n"); grid = -1; return; }
        if (hipOccupancyMaxActiveBlocksPerMultiprocessor(&per_cu, (const void*)mega_fwd, 512, LDS_BYTES) != hipSuccess || per_cu < 1) { fprintf(stderr, "kernel_launch: occupancy query says %d\n", per_cu); (void)hipGetLastError(); grid = -1; return; }
        grid = cus * per_cu; if (grid > 256) grid = 256;
        fprintf(stderr, "kernel_launch: grid %d (cus %d x %d)\n", grid, cus, per_cu);
    }
    if (grid < 0) return;
    (void)hipMemsetAsync((char*)d_ws + WS_MOD, 0, CTL_BYTES, stream);
    Args a{};
    for (int i = 0; i < 23; ++i) a.in[i] = (const float*)d_in[i];
    a.out = (float*)d_out; a.ws = (unsigned char*)d_ws;
#if MK_PER_PHASE
    for (int p = 0; p < NPHASE; ++p) { a.lo = p; a.hi = p + 1; hipLaunchKernelGGL(mega_fwd, dim3(grid), dim3(512), LDS_BYTES, stream, a); }
#else
    a.lo = 0; a.hi = NPHASE;
    void* kargs[] = {&a};
    hipError_t e = hipLaunchCooperativeKernel((const void*)mega_fwd, dim3(grid), dim3(512), kargs, LDS_BYTES, stream);
    if (e != hipSuccess) fprintf(stderr, "kernel_launch: cooperative launch failed: %s (grid %d)\n", hipGetErrorString(e), grid);
#endif
}
```

```cpp
#include <hip/hip_runtime.h>
#include <hip/hip_cooperative_groups.h>
#include <cstdio>
#include <cstdint>
namespace cg = cooperative_groups;
namespace pg8 {
#define PG8_LAS __attribute__((address_space(3)))
typedef unsigned short bf16_t;
typedef short bf16x8 __attribute__((ext_vector_type(8)));
typedef float f32x4 __attribute__((ext_vector_type(4)));
typedef unsigned u32x4 __attribute__((ext_vector_type(4)));
constexpr int BM = 256, BK = 64, HALF = 128, HTB = HALF * BK * 2  , STAGE_BYTES = 8 * HTB, NXCD = 8, WGM = 8;

__host__ __device__ __forceinline__ int lds_byte(int r, int c) { const int st = (r >> 4) * 2 + (c >> 5), rr = r & 15, cc = c & 31, ob = rr * 64 + cc * 2; return st * 1024 + (ob ^ (((ob >> 9) & 1) << 5)); }
__host__ __device__ __forceinline__ void stage_rc(int b, int& R, int& C) { const int st = b / 1024, sb = b % 1024, swz = sb ^ (((sb >> 9) & 1) << 5); R = (st >> 1) * 16 + swz / 64; C = (st & 1) * 32 + (swz % 64) / 2; }
__host__ __device__ __forceinline__ int perm32(int rho) { const int n = rho >> 4, i = rho & 15; return 8 * (i >> 2) + 4 * n + (i & 3); }

struct Unit { int pm, pn; };
struct Gemm { const bf16_t* A; const bf16_t* Bt; int M, N, K; };

struct StaticOrder {
    int nM, nN, nwg, G, c;
    __host__ __device__ void init(int M, int N, int G_, int c_) { nM = M / BM; nN = N / BM; nwg = nM * nN; G = G_; c = c_; }
    __host__ __device__ bool next(int i, Unit& u) const {
        const long L = (long)i * G + c; if (L >= nwg) return false;
        int wgid = (int)L; { const int q = nwg / NXCD, r = nwg % NXCD, xcd = wgid % NXCD, off = wgid / NXCD; wgid = (xcd < r ? xcd * (q + 1) : r * (q + 1) + (xcd - r) * q) + off; }
        const int nig = WGM * nN, gid = wgid / nig, fm = gid * WGM, gsz = (nM - fm) < WGM ? (nM - fm) : WGM;
        u.pm = fm + ((wgid % nig) % gsz); u.pn = (wgid % nig) / gsz; return true;
    }
    __device__ __forceinline__ void a_ready(const Unit&) const {}
    __device__ __forceinline__ void done(const Unit&) const {}
};
__device__ __forceinline__ unsigned cvt_pk_bf16(float lo, float hi) { unsigned r; asm volatile("v_cvt_pk_bf16_f32 %0, %1, %2" : "=v"(r) : "v"(lo), "v"(hi)); return r; }
template <class Epi, class Sched, bool ALIGN_EPI = false, bool SP2 = false>
__device__ __forceinline__ void gemm_phase(PG8_LAS unsigned char* lds, const Gemm g, const Sched& S, const Epi& E) {
    int tid_ = threadIdx.x; asm volatile("" : "+v"(tid_));
    const int tid = tid_, wid = __builtin_amdgcn_readfirstlane(tid >> 6), lane = tid & 63, wr = wid >> 2, wc = wid & 3, fr = lane & 15, fq = lane >> 4;
    const int K = g.K, nt = K / BK;
    unsigned voffA[2], voffB[2];
#pragma unroll
    for (int i = 0; i < 2; ++i) { int R, C; stage_rc(tid * 16 + i * 8192, R, C); const int Rb = Epi::PERM ? ((R & ~31) + perm32(R & 31)) : R;
        voffA[i] = (unsigned)(R * K + C) * 2u; voffB[i] = (unsigned)(Rb * K + C) * 2u; }
    const size_t kstep = (size_t)(BK * 2);
    const size_t hstep = (size_t)HALF * K * 2;
    const size_t tstep = 2 * hstep;
    const unsigned ldsw = (unsigned)wid * 1024u;
    const int aoff = lds_byte(wr * 64 + fr, fq * 8), boff = lds_byte(wc * 32 + fr, fq * 8);
#define PG8_SA(b, h) (((b) * 2 + (h)) * HTB)
#define PG8_SB(b, h) ((4 + (b) * 2 + (h)) * HTB)
#define PG8_STAGE(bufoff, gbase, voff) do { _Pragma("unroll") for (int _i = 0; _i < 2; ++_i) \
        __builtin_amdgcn_global_load_lds((const unsigned*)((const char*)(gbase) + (voff)[_i]), (PG8_LAS unsigned*)(lds + (bufoff) + ldsw + _i * 8192), 16, 0, 0); } while (0)
#define PG8_LDA(dst, b, h) do { _Pragma("unroll") for (int m = 0; m < 4; ++m) _Pragma("unroll") for (int k = 0; k < 2; ++k) dst[m][k] = *(const PG8_LAS bf16x8*)(lds + PG8_SA(b, h) + aoff + m * 2048 + k * 1024); } while (0)
#define PG8_LDB(dst, b, h) do { _Pragma("unroll") for (int n = 0; n < 2; ++n) _Pragma("unroll") for (int k = 0; k < 2; ++k) dst[n][k] = *(const PG8_LAS bf16x8*)(lds + PG8_SB(b, h) + boff + n * 2048 + k * 1024); } while (0)
#define PG8_MMA(ai, bj, At, Bt) do { __builtin_amdgcn_s_setprio(1); _Pragma("unroll") for (int m = 0; m < 4; ++m) _Pragma("unroll") for (int n = 0; n < 2; ++n) _Pragma("unroll") for (int k = 0; k < 2; ++k) \
        acc[ai][bj][m][n] = __builtin_amdgcn_mfma_f32_16x16x32_bf16(Bt[n][k], At[m][k], acc[ai][bj][m][n], 0, 0, 0); __builtin_amdgcn_s_setprio(0); } while (0)
#define PG8_WAIT_V(n) asm volatile("s_waitcnt vmcnt(" #n ")" ::: "memory")
#define PG8_WAIT_L(n) asm volatile("s_waitcnt lgkmcnt(" #n ")" ::: "memory")
#define PG8_BAR __builtin_amdgcn_s_barrier()
#define PG8_SCHED __builtin_amdgcn_sched_barrier(0)
    Unit cur, nxt; int ui = 0;
    if (!S.next(0, cur)) return;
    f32x4 acc[2][2][4][2];
#pragma unroll
    for (int a = 0; a < 2; ++a)
#pragma unroll
        for (int b = 0; b < 2; ++b)
#pragma unroll
            for (int m = 0; m < 4; ++m)
#pragma unroll
                for (int n = 0; n < 2; ++n) acc[a][b][m][n] = (f32x4){0.f, 0.f, 0.f, 0.f};
    bf16x8 At[4][2], B0[2][2], B1[2][2];
    const char* cA = (const char*)g.A + (size_t)cur.pm * tstep; const char* cB = (const char*)g.Bt + (size_t)cur.pn * tstep;
    S.a_ready(cur);
    if constexpr (SP2) {
        PG8_STAGE(PG8_SB(0, 0), cB, voffB); PG8_STAGE(PG8_SB(0, 1), cB + hstep, voffB); PG8_STAGE(PG8_SA(0, 0), cA, voffA); PG8_STAGE(PG8_SA(0, 1), cA + hstep, voffA);
        if (wr == 1) PG8_BAR;
        PG8_WAIT_V(2); PG8_BAR;
        PG8_STAGE(PG8_SB(1, 0), cB + kstep, voffB); PG8_STAGE(PG8_SA(1, 0), cA + kstep, voffA); PG8_STAGE(PG8_SB(1, 1), cB + hstep + kstep, voffB);
        PG8_WAIT_V(6); PG8_BAR;
    } else {
        PG8_STAGE(PG8_SB(0, 0), cB, voffB); PG8_STAGE(PG8_SA(0, 0), cA, voffA); PG8_STAGE(PG8_SB(0, 1), cB + hstep, voffB); PG8_STAGE(PG8_SA(0, 1), cA + hstep, voffA);
        if (wr == 1) PG8_BAR;
        PG8_WAIT_V(4); PG8_BAR;
        PG8_STAGE(PG8_SB(1, 0), cB + kstep, voffB); PG8_STAGE(PG8_SA(1, 0), cA + kstep, voffA); PG8_STAGE(PG8_SB(1, 1), cB + hstep + kstep, voffB);
        PG8_WAIT_V(6); PG8_BAR;
    }
    for (;;) {
        const bool has_next = S.next(ui + 1, nxt);
        const char* nA = has_next ? (const char*)g.A + (size_t)nxt.pm * tstep : cA; const char* nB = has_next ? (const char*)g.Bt + (size_t)nxt.pn * tstep : cB;
        for (int t = 0; t < nt; t += 2) {
            const bool last = (t == nt - 2);
            const char* a1 = cA + (size_t)(t + 1) * kstep;
            const char* a2 = last ? nA : cA + (size_t)(t + 2) * kstep; const char* b2 = last ? nB : cB + (size_t)(t + 2) * kstep;
            const char* a3 = a2 + kstep; const char* b3 = b2 + kstep;
            if (last && has_next) S.a_ready(nxt);
            if constexpr (SP2) {
            PG8_LDB(B0, 0, 0); PG8_LDB(B1, 0, 1); PG8_SCHED; PG8_LDA(At, 0, 0); PG8_STAGE(PG8_SA(1, 1), a1 + hstep, voffA);
            PG8_WAIT_V(8); PG8_WAIT_L(0); PG8_BAR; PG8_MMA(0, 0, At, B0); PG8_MMA(0, 1, At, B1); PG8_BAR; PG8_SCHED;
            PG8_LDA(At, 0, 1); PG8_STAGE(PG8_SB(0, 0), b2, voffB); PG8_STAGE(PG8_SB(0, 1), b2 + hstep, voffB); PG8_STAGE(PG8_SA(0, 0), a2, voffA);
            PG8_WAIT_V(8); PG8_WAIT_L(0); PG8_BAR; PG8_MMA(1, 0, At, B0); PG8_MMA(1, 1, At, B1); PG8_BAR; PG8_SCHED;
            PG8_LDB(B0, 1, 0); PG8_LDB(B1, 1, 1); PG8_SCHED; PG8_LDA(At, 1, 0); PG8_STAGE(PG8_SA(0, 1), a2 + hstep, voffA);
            PG8_WAIT_V(8); PG8_WAIT_L(0); PG8_BAR; PG8_MMA(0, 0, At, B0); PG8_MMA(0, 1, At, B1); PG8_BAR; PG8_SCHED;
            PG8_LDA(At, 1, 1); PG8_STAGE(PG8_SB(1, 0), b3, voffB); PG8_STAGE(PG8_SB(1, 1), b3 + hstep, voffB); PG8_STAGE(PG8_SA(1, 0), a3, voffA);
            PG8_WAIT_V(8); PG8_WAIT_L(0); PG8_BAR; PG8_MMA(1, 0, At, B0); PG8_MMA(1, 1, At, B1); PG8_BAR; PG8_SCHED;
            } else {
            PG8_LDB(B0, 0, 0); PG8_SCHED; PG8_LDA(At, 0, 0); PG8_STAGE(PG8_SA(1, 1), a1 + hstep, voffA);
            PG8_WAIT_L(8); PG8_BAR; PG8_WAIT_L(0); PG8_MMA(0, 0, At, B0); PG8_BAR; PG8_SCHED;
            PG8_LDB(B1, 0, 1); PG8_STAGE(PG8_SB(0, 0), b2, voffB);
            PG8_BAR; PG8_WAIT_L(0); PG8_MMA(0, 1, At, B1); PG8_BAR;
            PG8_LDA(At, 0, 1); PG8_STAGE(PG8_SA(0, 0), a2, voffA);
            PG8_BAR; PG8_WAIT_L(0); PG8_MMA(1, 0, At, B0); PG8_BAR; PG8_SCHED;
            PG8_STAGE(PG8_SB(0, 1), b2 + hstep, voffB);
            PG8_WAIT_V(6); PG8_BAR; PG8_MMA(1, 1, At, B1); PG8_BAR;
            PG8_LDB(B0, 1, 0); PG8_SCHED; PG8_LDA(At, 1, 0); PG8_STAGE(PG8_SA(0, 1), a2 + hstep, voffA);
            PG8_WAIT_L(8); PG8_BAR; PG8_WAIT_L(0); PG8_MMA(0, 0, At, B0); PG8_BAR; PG8_SCHED;
            PG8_LDB(B1, 1, 1); PG8_STAGE(PG8_SB(1, 0), b3, voffB);
            PG8_BAR; PG8_WAIT_L(0); PG8_MMA(0, 1, At, B1); PG8_BAR;
            PG8_LDA(At, 1, 1); PG8_STAGE(PG8_SA(1, 0), a3, voffA);
            PG8_BAR; PG8_WAIT_L(0); PG8_MMA(1, 0, At, B0); PG8_BAR; PG8_SCHED;
            PG8_STAGE(PG8_SB(1, 1), b3 + hstep, voffB);
            PG8_WAIT_V(6); PG8_BAR; PG8_MMA(1, 1, At, B1); PG8_BAR;
            }
        }
        if constexpr (ALIGN_EPI) { if (wr == 0) PG8_BAR; }
        if constexpr (!Epi::AFTER_DRAIN) { E(acc, cur, wr, wc, fr, fq); S.done(cur); }
        if (!has_next) break;
#pragma unroll
        for (int a = 0; a < 2; ++a)
#pragma unroll
            for (int b = 0; b < 2; ++b)
#pragma unroll
                for (int m = 0; m < 4; ++m)
#pragma unroll
                    for (int n = 0; n < 2; ++n) acc[a][b][m][n] = (f32x4){0.f, 0.f, 0.f, 0.f};
        cur = nxt; cA = nA; cB = nB; ++ui;
        if constexpr (ALIGN_EPI) { if (wr == 1) PG8_BAR; }
    }
    PG8_WAIT_V(0);
    if constexpr (!ALIGN_EPI) { if (wr == 0) PG8_BAR; }
    PG8_BAR;
    if constexpr (Epi::AFTER_DRAIN) { E.fused(acc, cur, wr, wc, fr, fq, lds, wid, lane); S.done(cur); }
#undef PG8_SA
#undef PG8_SB
#undef PG8_STAGE
#undef PG8_LDA
#undef PG8_LDB
#undef PG8_MMA
#undef PG8_WAIT_V
#undef PG8_WAIT_L
#undef PG8_BAR
#undef PG8_SCHED
}
}

constexpr int D = 1024, SEQ = 8192, M = 16384, CTXL = 256, MC = 512, MT = M + MC;
constexpr int NH = 8, DK = 192, DV = 128, QL = 384, KVL = 256, DIN = 5824, DINP = 5888, DFF = 2816, SKV = SEQ + CTXL;
constexpr float EPS = 1e-6f;
typedef unsigned short bf16_t;
typedef float f32x4 __attribute__((ext_vector_type(4)));
typedef unsigned u32x4 __attribute__((ext_vector_type(4)));
typedef unsigned u32x2 __attribute__((ext_vector_type(2)));
#define LAS __attribute__((address_space(3)))

constexpr size_t WS_MOD = 0;
constexpr size_t MOD_BYTES = 3 * 6144 * 4;
constexpr size_t WS_BAR = 81920, WS_ROWSS = 131072, CTL_BYTES = 131072 + 65536;
constexpr size_t WS_SHW = CTL_BYTES;
constexpr size_t WS_ROPE = WS_SHW + 65536;
constexpr size_t WS_WIN = WS_ROPE + (size_t)SEQ * 64 * 4;
constexpr size_t WS_KRB = WS_WIN;
constexpr size_t WS_KRSS = WS_KRB + (size_t)MT * 64 * 4;
constexpr size_t WS_WC = WS_WIN + (size_t)DINP * D * 2;
constexpr size_t WS_WQ = WS_WC + (size_t)D * D * 2;
constexpr size_t WS_WKV = WS_WQ + (size_t)1536 * QL * 2;
constexpr size_t WS_WA = WS_WKV + (size_t)2048 * KVL * 2;
constexpr size_t WS_WO = WS_WA + (size_t)D * D * 2;
constexpr size_t WS_WF1 = WS_WO + (size_t)D * D * 2;
constexpr size_t WS_WF2 = WS_WF1 + (size_t)2 * DFF * D * 2;
constexpr size_t WS_XN = WS_WF2 + (size_t)D * DFF * 2;
constexpr size_t WS_BX = WS_XN + (size_t)MT * D * 2;
constexpr size_t WS_QAN = WS_BX + (size_t)M * D * 2;
constexpr size_t WS_KVAN = WS_QAN + (size_t)M * QL * 2;
constexpr size_t WS_R = WS_KVAN + (size_t)MT * KVL * 2;
constexpr size_t WS_UU = WS_R;
constexpr size_t WS_QA = WS_UU + (size_t)M * D * 2;
constexpr size_t WS_KVA = WS_QA + (size_t)M * QL * 2;
constexpr size_t WS_Q = WS_R;
constexpr size_t WS_K = WS_Q + (size_t)M * 1536 * 2;
constexpr size_t WS_V = WS_K + (size_t)2 * NH * SKV * DK * 2;
constexpr size_t WS_H = WS_R;
constexpr size_t WS_END = WS_V + (size_t)2 * NH * SKV * DV * 2;
static_assert(WS_END <= 268435456ull, "d_ws map exceeds 256 MiB");
static_assert(WS_KVA + (size_t)MT * 320 * 2 <= WS_END && WS_H + (size_t)M * DFF * 2 <= WS_END, "overlay");
static_assert(WS_KRSS + (size_t)MT * 4 <= WS_WC, "KRB overlay");

constexpr int LDS_BYTES = 140 * 1024;

__device__ __forceinline__ unsigned pk2(float lo, float hi) { return pg8::cvt_pk_bf16(lo, hi); }
__device__ __forceinline__ float bflo(unsigned w) { return __uint_as_float(w << 16); }
__device__ __forceinline__ float bfhi(unsigned w) { return __uint_as_float(w & 0xffff0000u); }
__device__ __forceinline__ float bf1(bf16_t h) { return __uint_as_float(((unsigned)h) << 16); }
__device__ __forceinline__ bf16_t f2bf1(float f) { return (bf16_t)(pk2(f, f) & 0xffffu); }
__device__ __forceinline__ void unpack8(u32x4 w, float* v) {
    v[0] = bflo(w.x); v[1] = bfhi(w.x); v[2] = bflo(w.y); v[3] = bfhi(w.y); v[4] = bflo(w.z); v[5] = bfhi(w.z); v[6] = bflo(w.w); v[7] = bfhi(w.w);
}
__device__ __forceinline__ u32x4 pack8(const float* v) { u32x4 w; w.x = pk2(v[0], v[1]); w.y = pk2(v[2], v[3]); w.z = pk2(v[4], v[5]); w.w = pk2(v[6], v[7]); return w; }
__device__ __forceinline__ u32x4 pack8v(f32x4 a, f32x4 b) { u32x4 w; w.x = pk2(a[0], a[1]); w.y = pk2(a[2], a[3]); w.z = pk2(b[0], b[1]); w.w = pk2(b[2], b[3]); return w; }
__device__ __forceinline__ unsigned pk4_fp8(float a, float b, float c, float d) { int w = 0; w = __builtin_amdgcn_cvt_pk_fp8_f32(a, b, w, false); w = __builtin_amdgcn_cvt_pk_fp8_f32(c, d, w, true); return (unsigned)w; }
__device__ __forceinline__ float wave_sum(float v) {
#pragma unroll
    for (int o = 1; o < 64; o <<= 1) v += __shfl_xor(v, o);
    return v;
}
__device__ __forceinline__ float sigmoidf_(float x) { return __builtin_amdgcn_rcpf(1.f + __expf(-x)); }
__device__ __forceinline__ float siluf_(float x) { return x * sigmoidf_(x); }

template <class F> struct Epi8 {
    static constexpr bool PERM = true, AFTER_DRAIN = false;
    F f;
    __device__ __forceinline__ void operator()(const pg8::f32x4 (&acc)[2][2][4][2], const pg8::Unit& u, int wr, int wc, int fr, int fq) const {
        const int cl = wc * 32 + 8 * fq;
#pragma unroll
        for (int ai = 0; ai < 2; ++ai)
#pragma unroll
            for (int m = 0; m < 4; ++m) {
                const int row = u.pm * 256 + ai * 128 + wr * 64 + m * 16 + fr;
                f(row, u.pn, cl, acc[ai][0][m][0], acc[ai][0][m][1], acc[ai][1][m][0], acc[ai][1][m][1]);
            }
    }
};
#define ST8(p, a, b) (*(u32x4*)(p) = pack8v((a), (b)))

struct FIn {
    bf16_t *BX, *UU, *QA, *KVA, *SGC, *SGA; const float* bgate;
    __device__ __forceinline__ void operator()(int row, int pn, int cl, f32x4 a0, f32x4 a1, f32x4 b0, f32x4 b1) const {
        if (pn < 4) { if (row < M) { bf16_t* p = BX + (size_t)row * D + pn * 256 + cl; ST8(p, a0, a1); ST8(p + 128, b0, b1); } }
        else if (pn < 12) { if (row < M) { bf16_t* p = UU + (size_t)row * D + (pn - 4) * 128 + cl; ST8(p, a0 * b0, a1 * b1); } }
        else if (pn < 15) {
            const int d0 = (pn - 12) * 256 + cl, d1 = d0 + 128;
            if (d0 < 384) { if (row < M) ST8(QA + (size_t)row * QL + d0, a0, a1); } else if (d0 < 704) ST8(KVA + (size_t)row * 320 + (d0 - 384), a0, a1);
            if (d1 < 384) { if (row < M) ST8(QA + (size_t)row * QL + d1, b0, b1); } else if (d1 < 704) ST8(KVA + (size_t)row * 320 + (d1 - 384), b0, b1);
        } else if (row < M) {
            const bool isa = pn >= 19; const int col = (pn - (isa ? 19 : 15)) * 256 + cl;
            const float* bg = bgate + (isa ? D : 0) + col; bf16_t* p = (isa ? SGA : SGC) + (size_t)row * D + col;
            const f32x4 g0 = *(const f32x4*)bg, g1 = *(const f32x4*)(bg + 4), g2 = *(const f32x4*)(bg + 128), g3 = *(const f32x4*)(bg + 132);
            f32x4 s0, s1, s2, s3;
#pragma unroll
            for (int i = 0; i < 4; ++i) { s0[i] = sigmoidf_(a0[i] + g0[i]); s1[i] = sigmoidf_(a1[i] + g1[i]); s2[i] = sigmoidf_(b0[i] + g2[i]); s3[i] = sigmoidf_(b1[i] + g3[i]); }
            ST8(p, s0, s1); ST8(p + 128, s2, s3);
        }
    }
};
struct FConv {
    const bf16_t* SGC; bf16_t* Z1;
    __device__ __forceinline__ void operator()(int row, int pn, int cl, f32x4 a0, f32x4 a1, f32x4 b0, f32x4 b1) const {
        const size_t o = (size_t)row * D + pn * 256 + cl; float g[8], h[8];
        unpack8(*(const u32x4*)(SGC + o), g); unpack8(*(const u32x4*)(SGC + o + 128), h);
        float r0[8], r1[8];
#pragma unroll
        for (int i = 0; i < 4; ++i) { r0[i] = g[i] * a0[i]; r0[4 + i] = g[4 + i] * a1[i]; r1[i] = h[i] * b0[i]; r1[4 + i] = h[4 + i] * b1[i]; }
        *(u32x4*)(Z1 + o) = pack8(r0); *(u32x4*)(Z1 + o + 128) = pack8(r1);
    }
};
struct FQ {
    bf16_t* Q;
    __device__ __forceinline__ void operator()(int row, int pn, int cl, f32x4 a0, f32x4 a1, f32x4 b0, f32x4 b1) const {
        bf16_t* p = Q + (size_t)row * 1536 + pn * 256 + cl; ST8(p, a0, a1); ST8(p + 128, b0, b1);
    }
};
struct EpiK2 {
    static constexpr bool PERM = true, AFTER_DRAIN = false;
    unsigned char* K; const float *KRB, *KRSS, *knorm; LAS float* T;
    __device__ __forceinline__ void operator()(const pg8::f32x4 (&acc)[2][2][4][2], const pg8::Unit& u, int wr, int wc, int fr, int fq) const {
        int tid = threadIdx.x; asm volatile("" : "+v"(tid));
        asm volatile("" : "+v"(fr), "+v"(fq)); LAS float* S = T + 2048;
#pragma unroll
        for (int ai = 0; ai < 2; ++ai)
#pragma unroll
            for (int m = 0; m < 4; ++m)
#pragma unroll
                for (int bj = 0; bj < 2; ++bj) { const f32x4 a = acc[ai][bj][m][0], b = acc[ai][bj][m][1];
                    float ss = (a[0] * a[0] + a[1] * a[1]) + (a[2] * a[2] + a[3] * a[3]) + (b[0] * b[0] + b[1] * b[1]) + (b[2] * b[2] + b[3] * b[3]);
                    ss += __shfl_xor(ss, 16); ss += __shfl_xor(ss, 32);
                    if (fq == 0) T[((ai * 128 + wr * 64 + m * 16 + fr) * 2 + bj) * 4 + wc] = ss; }
        asm volatile("s_waitcnt lgkmcnt(0)" ::: "memory"); __builtin_amdgcn_s_barrier(); asm volatile("" ::: "memory");
        { const int grow = u.pm * 256 + (tid >> 1); const float ss = (T[tid * 4] + T[tid * 4 + 1]) + (T[tid * 4 + 2] + T[tid * 4 + 3]) + KRSS[grow];
          S[tid] = rsqrtf(ss * (1.f / DK) + EPS); }
        asm volatile("s_waitcnt lgkmcnt(0)" ::: "memory"); __builtin_amdgcn_s_barrier(); asm volatile("" ::: "memory");
        const int cl = wc * 32 + 8 * fq; const f32x4 g0 = *(const f32x4*)(knorm + cl), g1 = *(const f32x4*)(knorm + cl + 4);
#pragma unroll
        for (int ai = 0; ai < 2; ++ai)
#pragma unroll
            for (int m = 0; m < 4; ++m) { const int rl = ai * 128 + wr * 64 + m * 16 + fr, row = u.pm * 256 + rl;
                int b, pos; if (row < M) { b = row >> 13; pos = CTXL + (row & (SEQ - 1)); } else { b = (row - M) >> 8; pos = (row - M) & (CTXL - 1); }
#pragma unroll
                for (int bj = 0; bj < 2; ++bj) { const float r = S[rl * 2 + bj]; const size_t o = (size_t)(b * NH + 2 * u.pn + bj) * SKV + pos;
                    const f32x4 k0 = acc[ai][bj][m][0] * g0 * r, k1 = acc[ai][bj][m][1] * g1 * r; u32x2 w; w.x = pk4_fp8(k0[0], k0[1], k0[2], k0[3]); w.y = pk4_fp8(k1[0], k1[1], k1[2], k1[3]);
                    *(u32x2*)(K + o * DK + cl) = w; } }
        { const int rl = tid >> 1, bj = tid & 1, row = u.pm * 256 + rl; const float r = S[tid];
          int b, pos; if (row < M) { b = row >> 13; pos = CTXL + (row & (SEQ - 1)); } else { b = (row - M) >> 8; pos = (row - M) & (CTXL - 1); }
          unsigned char* p = K + ((size_t)(b * NH + 2 * u.pn + bj) * SKV + pos) * DK + 128; const float* kb = KRB + (size_t)row * 64;
#pragma unroll 1
          for (int i = 0; i < 4; ++i) { const f32x4 x0 = *(const f32x4*)(kb + 16 * i) * r, x1 = *(const f32x4*)(kb + 16 * i + 4) * r, x2 = *(const f32x4*)(kb + 16 * i + 8) * r, x3 = *(const f32x4*)(kb + 16 * i + 12) * r;
              u32x4 w; w.x = pk4_fp8(x0[0], x0[1], x0[2], x0[3]); w.y = pk4_fp8(x1[0], x1[1], x1[2], x1[3]); w.z = pk4_fp8(x2[0], x2[1], x2[2], x2[3]); w.w = pk4_fp8(x3[0], x3[1], x3[2], x3[3]);
              *(u32x4*)(p + 16 * i) = w; } }
    }
};
struct FVt {
    unsigned char* Vt;
    __device__ __forceinline__ void operator()(int row, int pn, int cl, f32x4 a0, f32x4 a1, f32x4 b0, f32x4 b1) const {
        const int h = row >> 7, c = row & 127;
#pragma unroll
        for (int bj = 0; bj < 2; ++bj) { const int t0 = pn * 256 + bj * 128 + cl;
            int b, pos; if (t0 < M) { b = t0 >> 13; pos = CTXL + (t0 & (SEQ - 1)); } else { b = (t0 - M) >> 8; pos = (t0 - M) & (CTXL - 1); }
            const f32x4 x = bj ? b0 : a0, y = bj ? b1 : a1; u32x2 w; w.x = pk4_fp8(x[0], x[1], x[2], x[3]); w.y = pk4_fp8(y[0], y[1], y[2], y[3]);
            *(u32x2*)(Vt + ((((size_t)(b * NH + h) * (SKV / 64) + (pos >> 6)) * 128 + c) << 6) + (pos & 63)) = w; }
    }
};
struct FAo {
    const bf16_t* SGA; bf16_t* Z;
    __device__ __forceinline__ void operator()(int row, int pn, int cl, f32x4 a0, f32x4 a1, f32x4 b0, f32x4 b1) const {
        const size_t o = (size_t)row * D + pn * 256 + cl; float g[8], h[8], z0[8], z1[8];
        unpack8(*(const u32x4*)(SGA + o), g); unpack8(*(const u32x4*)(SGA + o + 128), h);
        unpack8(*(const u32x4*)(Z + o), z0); unpack8(*(const u32x4*)(Z + o + 128), z1);
#pragma unroll
        for (int i = 0; i < 4; ++i) { z0[i] += g[i] * a0[i]; z0[4 + i] += g[4 + i] * a1[i]; z1[i] += h[i] * b0[i]; z1[4 + i] += h[4 + i] * b1[i]; }
        *(u32x4*)(Z + o) = pack8(z0); *(u32x4*)(Z + o + 128) = pack8(z1);
    }
};
struct FRes {
    const float* base; float* out; const float* gate;
    __device__ __forceinline__ void operator()(int row, int pn, int cl, f32x4 a0, f32x4 a1, f32x4 b0, f32x4 b1) const {
        const int col = pn * 256 + cl; const size_t o = (size_t)row * D + col; const float* g = gate + (row >> 13) * 6144 + col;
        const f32x4 x0 = *(const f32x4*)(base + o), x1 = *(const f32x4*)(base + o + 4), x2 = *(const f32x4*)(base + o + 128), x3 = *(const f32x4*)(base + o + 132);
        const f32x4 g0 = *(const f32x4*)g, g1 = *(const f32x4*)(g + 4), g2 = *(const f32x4*)(g + 128), g3 = *(const f32x4*)(g + 132);
        *(f32x4*)(out + o) = x0 + g0 * a0; *(f32x4*)(out + o + 4) = x1 + g1 * a1; *(f32x4*)(out + o + 128) = x2 + g2 * b0; *(f32x4*)(out + o + 132) = x3 + g3 * b1;
    }
};
struct FRes2 {
    const float* base; float* out; const float* mod; const float* nffn; bf16_t* HX2; float* ROWSS;
    __device__ __forceinline__ void operator()(int row, int pn, int cl, f32x4 a0, f32x4 a1, f32x4 b0, f32x4 b1) const {
        const int col = pn * 256 + cl; const size_t o = (size_t)row * D + col; const float* md = mod + (row >> 13) * 6144 + col;
        const f32x4 x0 = *(const f32x4*)(base + o), x1 = *(const f32x4*)(base + o + 4), x2 = *(const f32x4*)(base + o + 128), x3 = *(const f32x4*)(base + o + 132);
        const float* g = md + 2 * D; const f32x4 g0 = *(const f32x4*)g, g1 = *(const f32x4*)(g + 4), g2 = *(const f32x4*)(g + 128), g3 = *(const f32x4*)(g + 132);
        const f32x4 y0 = x0 + g0 * a0, y1 = x1 + g1 * a1, y2 = x2 + g2 * b0, y3 = x3 + g3 * b1;
        *(f32x4*)(out + o) = y0; *(f32x4*)(out + o + 4) = y1; *(f32x4*)(out + o + 128) = y2; *(f32x4*)(out + o + 132) = y3;
        const f32x4 q = y0 * y0 + y1 * y1 + y2 * y2 + y3 * y3; float ss = (q[0] + q[1]) + (q[2] + q[3]);
        ss += __shfl_xor(ss, 16); ss += __shfl_xor(ss, 32);
        if ((threadIdx.x & 48) == 0) unsafeAtomicAdd(ROWSS + row, ss);
        const float* sc = md + 4 * D; const float* nf = nffn + col;
        const f32x4 s0 = *(const f32x4*)sc + 1.f, s1 = *(const f32x4*)(sc + 4) + 1.f, s2 = *(const f32x4*)(sc + 128) + 1.f, s3 = *(const f32x4*)(sc + 132) + 1.f;
        const f32x4 n0 = *(const f32x4*)nf, n1 = *(const f32x4*)(nf + 4), n2 = *(const f32x4*)(nf + 128), n3 = *(const f32x4*)(nf + 132);
        ST8(HX2 + o, y0 * n0 * s0, y1 * n1 * s1); ST8(HX2 + o + 128, y2 * n2 * s2, y3 * n3 * s3);
    }
};
struct FFfn1 {
    bf16_t* H; const float* ROWSS; const float* SHW;
    __device__ __forceinline__ void operator()(int row, int pn, int cl, f32x4 a0, f32x4 a1, f32x4 b0, f32x4 b1) const {
        const float r = rsqrtf(ROWSS[row] * (1.f / D) + EPS); const float* sw = SHW + (row >> 13) * (2 * DFF) + pn * 256 + cl;
        const f32x4 c0 = *(const f32x4*)sw, c1 = *(const f32x4*)(sw + 4), c2 = *(const f32x4*)(sw + 128), c3 = *(const f32x4*)(sw + 132);
        a0 = a0 * r + c0; a1 = a1 * r + c1; b0 = b0 * r + c2; b1 = b1 * r + c3;
        f32x4 h0, h1;
#pragma unroll
        for (int i = 0; i < 4; ++i) { h0[i] = siluf_(a0[i]) * b0[i]; h1[i] = siluf_(a1[i]) * b1[i]; }
        ST8(H + (size_t)row * DFF + pn * 128 + cl, h0, h1);
    }
};

namespace att {
using bf16x8 = __attribute__((ext_vector_type(8))) short;
using s16x4 = __attribute__((ext_vector_type(4))) short;
using f32x16 = __attribute__((ext_vector_type(16))) float;
using v8i = __attribute__((ext_vector_type(8))) int;
constexpr int NW = 8, QBLK = 32, KVBLK = 64, LDQ = 1536, LDO = 1024;
constexpr float SCALE = 0.07216878364870322f;
constexpr float THR = 3.3f;
constexpr float PSHIFT = 4.f;
constexpr float QC = SCALE * 1.4426950408889634f;
constexpr float THRL = THR * 1.4426950408889634f;
constexpr int KROW = 208;
constexpr int VROW = 80;
constexpr int SHM_V = DV * VROW, SHM_K = KVBLK * KROW;
constexpr int SLOT = SHM_K + SHM_V, NSLOT = 5;
constexpr int LDS_WS = NSLOT * SLOT, LDS_ATT = LDS_WS + NW * 64 * 4;
#define SBAR() __builtin_amdgcn_sched_barrier(0)
__device__ __forceinline__ int crow(int r, int hi) { return (r & 3) + 8 * (r >> 2) + 4 * hi; }
__device__ __forceinline__ unsigned cvtpk(float lo, float hi) { unsigned r; asm volatile("v_cvt_pk_bf16_f32 %0, %1, %2" : "=v"(r) : "v"(lo), "v"(hi)); return r; }
__device__ __forceinline__ void smx(f32x16& p0, f32x16& p1, f32x16& q0, f32x16& q1, float& nm, f32x16& negm, float& alpha, float& l_reg, bool first, v8i& pf) {
    float pmax = p0[0];
#pragma unroll
    for (int r = 1; r < 16; ++r) pmax = fmaxf(pmax, p0[r]);
#pragma unroll
    for (int r = 0; r < 16; ++r) pmax = fmaxf(pmax, p1[r]);
    { auto rr = __builtin_amdgcn_permlane32_swap(__float_as_uint(pmax), __float_as_uint(pmax), false, false);
      pmax = fmaxf(__uint_as_float(rr[0]), __uint_as_float(rr[1])); }
    alpha = 1.f;
    if (__builtin_expect(first || __any(pmax > PSHIFT + THRL), 0)) {
        asm volatile("" ::: "memory");
        const float delta = first ? pmax - PSHIFT : fmaxf(pmax - PSHIFT, 0.f);
        nm -= delta; alpha = __builtin_amdgcn_exp2f(-delta);
#pragma unroll
        for (int r = 0; r < 16; ++r) { p0[r] -= delta; p1[r] -= delta; q0[r] -= delta; q1[r] -= delta; negm[r] = nm; }
        asm volatile("" : "+v"(negm));
    }
#pragma unroll
    for (int r = 0; r < 16; ++r) p0[r] = __builtin_amdgcn_exp2f(p0[r]);
#pragma unroll
    for (int r = 0; r < 16; ++r) p1[r] = __builtin_amdgcn_exp2f(p1[r]);
    float ps = 0;
#pragma unroll
    for (int r = 0; r < 16; ++r) ps += p0[r];
#pragma unroll
    for (int r = 0; r < 16; ++r) ps += p1[r];
    { auto rr = __builtin_amdgcn_permlane32_swap(__float_as_uint(ps), __float_as_uint(ps), false, false);
      ps = __uint_as_float(rr[0]) + __uint_as_float(rr[1]); }
    l_reg = l_reg * alpha + ps;
#pragma unroll
    for (int i = 0; i < 4; ++i) { pf[i] = (int)pk4_fp8(p0[4 * i], p0[4 * i + 1], p0[4 * i + 2], p0[4 * i + 3]); pf[4 + i] = (int)pk4_fp8(p1[4 * i], p1[4 * i + 1], p1[4 * i + 2], p1[4 * i + 3]); }
}
__device__ __forceinline__ void qkt(f32x16& p0, f32x16& p1, const char* Ks, const v8i* qf, const f32x16& negm, int r32, int hi) {
    p0 = negm; p1 = negm;
    const char* kp = Ks + r32 * KROW + 32 * hi;
#define KLD(s, X0, X1, Y0, Y1) const u32x4 X0 = *reinterpret_cast<const u32x4*>(kp + 64 * (s)), X1 = *reinterpret_cast<const u32x4*>(kp + 64 * (s) + 16), \
    Y0 = *reinterpret_cast<const u32x4*>(kp + 32 * KROW + 64 * (s)), Y1 = *reinterpret_cast<const u32x4*>(kp + 32 * KROW + 64 * (s) + 16)
#define KMM(s, X0, X1, Y0, Y1) do { const v8i A0 = {(int)X0.x, (int)X0.y, (int)X0.z, (int)X0.w, (int)X1.x, (int)X1.y, (int)X1.z, (int)X1.w}; \
    const v8i A1 = {(int)Y0.x, (int)Y0.y, (int)Y0.z, (int)Y0.w, (int)Y1.x, (int)Y1.y, (int)Y1.z, (int)Y1.w}; \
    p0 = __builtin_amdgcn_mfma_scale_f32_32x32x64_f8f6f4(A0, qf[s], p0, 0, 0, 0, 0, 0, 0); \
    p1 = __builtin_amdgcn_mfma_scale_f32_32x32x64_f8f6f4(A1, qf[s], p1, 0, 0, 0, 0, 0, 0); } while (0)
    KLD(0, a0, a1, a2, a3);
    KLD(1, b0, b1, b2, b3); KMM(0, a0, a1, a2, a3); __builtin_amdgcn_sched_barrier(0x40E);
    KLD(2, c0, c1, c2, c3); KMM(1, b0, b1, b2, b3);
    KMM(2, c0, c1, c2, c3);
#undef KLD
#undef KMM
}
__device__ __forceinline__ void pv_d0(f32x16* o, const char* Vs, const v8i pf, int r32, int hi) {
    const char* vp = Vs + r32 * VROW + 16 * hi;
#pragma unroll
    for (int d0 = 0; d0 < 4; ++d0) {
        const u32x4 x0 = *reinterpret_cast<const u32x4*>(vp + d0 * 32 * VROW), x1 = *reinterpret_cast<const u32x4*>(vp + d0 * 32 * VROW + 32);
        const v8i B = {(int)x0.x, (int)x0.y, (int)x0.z, (int)x0.w, (int)x1.x, (int)x1.y, (int)x1.z, (int)x1.w};
        o[d0] = __builtin_amdgcn_mfma_scale_f32_32x32x64_f8f6f4(pf, B, o[d0], 0, 0, 0, 0, 0, 0);
        if (d0 == 1) __builtin_amdgcn_sched_barrier(0x40E); }
}
__device__ __forceinline__ void attn_unit(const bf16_t* __restrict__ Qb, const unsigned char* __restrict__ Kh, const unsigned char* __restrict__ Vh, bf16_t* __restrict__ Ob, char* lds, LAS unsigned char* ldsl,
                                          const float* __restrict__ qnorm, const float* __restrict__ rope, int tl0) {
    int tid = threadIdx.x; asm volatile("" : "+v"(tid));
    const int wid = tid >> 6, lane = tid & 63, r32 = lane & 31, hi = lane >> 5;
    char* ring = lds;
    unsigned doff[3];
#pragma unroll
    for (int k = 0; k < 3; ++k) { const int ii = wid + 8 * k, p = ii * 1024 + lane * 16;
        const int row = p / KROW, col = p - row * KROW, rr = row & 31, key = (row & 32) | (((rr >> 2) & 1) << 4) | (rr & 3) | ((rr >> 3) << 2); const int dk = col < DK ? key * DK + col : 0;
        const int pv = p - SHM_K, c = pv / VROW, cv = pv - c * VROW; const int dv = cv < 64 ? c * 64 + cv : 0;
        doff[k] = (unsigned)(ii < 13 ? dk : dv); }
    unsigned dpk = doff[0] | (doff[1] << 16), dp2 = doff[2];
    asm volatile("" : "+v"(dpk), "+v"(dp2));
    float* ws = (float*)(lds + LDS_WS) + wid * 64; float* al_l = ws;
    v8i qf[3];
    {
        const bf16_t* Qr = Qb + (size_t)(wid * QBLK + r32) * LDQ + 32 * hi; float ss = 0.f;
#pragma unroll
        for (int c = 0; c < 12; ++c) { float v[8]; unpack8(*reinterpret_cast<const u32x4*>(Qr + 64 * (c >> 2) + 8 * (c & 3)), v);
#pragma unroll
            for (int i = 0; i < 8; ++i) ss += v[i] * v[i];
            if ((c & 3) == 3) asm volatile("" ::: "memory"); }
        { auto rr = __builtin_amdgcn_permlane32_swap(__float_as_uint(ss), __float_as_uint(ss), false, false); ss = __uint_as_float(rr[0]) + __uint_as_float(rr[1]); }
        const float rq = rsqrtf(ss * (1.f / DK) + EPS);
        asm volatile("" ::: "memory");
#pragma unroll
        for (int s = 0; s < 2; ++s)
#pragma unroll
            for (int c = 0; c < 4; ++c) { float v[8]; unpack8(*reinterpret_cast<const u32x4*>(Qr + 64 * s + 8 * c), v); const float* g = qnorm + 64 * s + 32 * hi + 8 * c;
#pragma unroll
                for (int i = 0; i < 8; ++i) v[i] = v[i] * (rq * QC) * g[i];
                qf[s][2 * c] = (int)pk4_fp8(v[0], v[1], v[2], v[3]); qf[s][2 * c + 1] = (int)pk4_fp8(v[4], v[5], v[6], v[7]);
                asm volatile("" ::: "memory"); }
        const float* rt = rope + (size_t)(tl0 + wid * QBLK + r32) * 64 + hi * 16; const float* g = qnorm + 128 + 32 * hi;
#pragma unroll
        for (int c = 0; c < 2; ++c) { float x1[8], x2[8], oa[8], ob[8]; unpack8(*reinterpret_cast<const u32x4*>(Qr + 128 + 8 * c), x1); unpack8(*reinterpret_cast<const u32x4*>(Qr + 144 + 8 * c), x2);
#pragma unroll
            for (int i = 0; i < 8; ++i) { const float a = x1[i] * (rq * QC) * g[8 * c + i], b = x2[i] * (rq * QC) * g[16 + 8 * c + i], cs = rt[8 * c + i], sn = rt[32 + 8 * c + i]; oa[i] = a * cs - b * sn; ob[i] = a * sn + b * cs; }
            qf[2][2 * c] = (int)pk4_fp8(oa[0], oa[1], oa[2], oa[3]); qf[2][2 * c + 1] = (int)pk4_fp8(oa[4], oa[5], oa[6], oa[7]);
            qf[2][4 + 2 * c] = (int)pk4_fp8(ob[0], ob[1], ob[2], ob[3]); qf[2][4 + 2 * c + 1] = (int)pk4_fp8(ob[4], ob[5], ob[6], ob[7]);
            asm volatile("" ::: "memory"); }
    }
    asm volatile("" : "+v"(qf[0]), "+v"(qf[1]), "+v"(qf[2]));
    float nm = 0.f, l_reg = 0.f; f32x16 o[4] = {}, negm = {};
    const int wuni = __builtin_amdgcn_readfirstlane(wid);
#define KOF(s) ((s) * SLOT)
#define VOF(s) ((s) * SLOT + SHM_K)
#define NEXT(s) ((s) == NSLOT - 1 ? 0 : (s) + 1)
#define DMA(t, s) do { const unsigned char* kt_ = Kh + (size_t)(t) * (KVBLK * DK); const unsigned char* vt_ = Vh + (size_t)(t) * (KVBLK * DV); \
    _Pragma("unroll") for (int k_ = 0; k_ < 3; ++k_) { const int ii_ = wuni + 8 * k_; if (ii_ < 23) \
        __builtin_amdgcn_global_load_lds((const unsigned*)((ii_ < 13 ? kt_ : vt_) + (k_ == 0 ? (dpk & 0xffffu) : k_ == 1 ? (dpk >> 16) : dp2)), (LAS unsigned*)(ldsl + (s) * SLOT + ii_ * 1024), 16, 0, 0); } } while (0)
#define DWAIT() asm volatile("s_waitcnt vmcnt(0)" ::: "memory")
#define RESC(a) do { if (__any((a) < 1.f)) { if (hi == 0) al_l[r32] = (a); asm volatile("s_waitcnt lgkmcnt(0)" ::: "memory"); \
    _Pragma("unroll") for (int r = 0; r < 16; ++r) { const float f_ = al_l[crow(r, hi)]; _Pragma("unroll") for (int d = 0; d < 4; ++d) o[d][r] *= f_; } } } while (0)
    f32x16 pA0, pA1, pB0, pB1; float alA; v8i pf; constexpr int NT = SKV / KVBLK;
    DMA(0, 0); DMA(1, 1); DMA(2, 2); DWAIT(); __syncthreads();
    if (wuni >= 4) __builtin_amdgcn_s_setprio(1);
    qkt(pA0, pA1, ring + KOF(0), qf, negm, r32, hi);
    int s0 = 0;
    for (int j = 0; j < NT; j += 2) {
        const int s1 = NEXT(s0), s2 = NEXT(s1), s3 = NEXT(s2), s4 = NEXT(s3);
        if (j + 3 < NT) DMA(j + 3, s3); if (j + 4 < NT) DMA(j + 4, s4);
        qkt(pB0, pB1, ring + KOF(s1), qf, negm, r32, hi);
        smx(pA0, pA1, pB0, pB1, nm, negm, alA, l_reg, j == 0, pf); RESC(alA);
        pv_d0(o, ring + VOF(s0), pf, r32, hi);
        if (j + 2 < NT) qkt(pA0, pA1, ring + KOF(s2), qf, negm, r32, hi);
        smx(pB0, pB1, pA0, pA1, nm, negm, alA, l_reg, false, pf); RESC(alA);
        pv_d0(o, ring + VOF(s1), pf, r32, hi);
        DWAIT(); __syncthreads();
        s0 = s2;
    }
    if (hi == 0) al_l[r32] = l_reg; asm volatile("s_waitcnt lgkmcnt(0)" ::: "memory");
    float rli[16];
#pragma unroll
    for (int r = 0; r < 16; ++r) rli[r] = __builtin_amdgcn_rcpf(al_l[crow(r, hi)]);
    bf16_t* Ow = Ob + (size_t)(wid * QBLK) * LDO;
#pragma unroll
    for (int r = 0; r < 16; ++r) { const int orow = crow(r, hi);
#pragma unroll
        for (int d0 = 0; d0 < 4; ++d0) Ow[(size_t)orow * LDO + d0 * 32 + r32] = f2bf1(o[d0][r] * rli[r]); }
    __builtin_amdgcn_s_setprio(0);
    __syncthreads();
#undef DMA
#undef DWAIT
#undef KOF
#undef VOF
#undef NEXT
#undef RESC
}
#undef SBAR
}
static_assert(att::LDS_ATT <= 131072, "attention LDS");

enum { MAP_ID = 0, MAP_WIN = 1, MAP_FF1 = 2, MAP_KV = 3 };
__device__ __forceinline__ int map_row(int mode, int n0) {
    if (mode == MAP_WIN) {
        if (n0 < 1024) return n0;
        if (n0 < 2048) { const int j = (n0 - 1024) >> 7, r = (n0 - 1024) & 127; return 1024 + 256 * j + r; }
        if (n0 < 3072) { const int j = (n0 - 2048) >> 7, r = (n0 - 2048) & 127; return 1024 + 256 * j + 128 + r; }
        if (n0 < 3776) return n0;
        return n0 + 64;
    } else if (mode == MAP_KV) {
        const int h = n0 >> 8, j = n0 & 255; return j < 128 ? h * 128 + j : 1024 + h * 128 + (j - 128);
    } else if (mode == MAP_FF1) {
        if (n0 < DFF) { const int j = n0 >> 7, r = n0 & 127; return 256 * j + r; }
        const int n1 = n0 - DFF, j = n1 >> 7, r = n1 & 127; return 256 * j + 128 + r;
    }
    return n0;
}
__device__ __forceinline__ void transpose_item(const float* W, int K, int N, bf16_t* WT, int mode, LAS float* scr, int item, int lane) {
    const int nblk = N / 32, kb = item / nblk, nb = item % nblk, k0 = 64 * kb, n0 = 32 * nb;
    float t_[32];
#pragma unroll
    for (int i = 0; i < 32; ++i) t_[i] = W[(size_t)(k0 + 2 * i + (lane >> 5)) * N + n0 + (lane & 31)];
#pragma unroll
    for (int i = 0; i < 32; ++i) scr[(2 * i + (lane >> 5)) * 33 + (lane & 31)] = t_[i];
    asm volatile("s_waitcnt lgkmcnt(0)" ::: "memory");
    const int c = lane & 7, dr0 = map_row(mode, n0);
#pragma unroll
    for (int j = 0; j < 4; ++j) { const int n = (lane >> 3) + 8 * j; const LAS float* s = scr + (8 * c) * 33 + n;
        u32x4 o; o.x = pk2(s[0 * 33], s[1 * 33]); o.y = pk2(s[2 * 33], s[3 * 33]); o.z = pk2(s[4 * 33], s[5 * 33]); o.w = pk2(s[6 * 33], s[7 * 33]);
        *(u32x4*)(WT + (size_t)(dr0 + n) * K + k0 + 8 * c) = o; }
    asm volatile("s_waitcnt lgkmcnt(0)" ::: "memory");
}
__device__ __forceinline__ void norm_mod_row(const float* __restrict__ xrow, const float* __restrict__ gain, const float* __restrict__ shift, const float* __restrict__ scale, bf16_t* __restrict__ orow, int lane) {
    const f32x4* xr = (const f32x4*)xrow + lane; f32x4 v[4]; float s = 0.f;
#pragma unroll
    for (int j = 0; j < 4; ++j) { v[j] = __builtin_nontemporal_load(xr + 64 * j); s += (v[j].x * v[j].x + v[j].y * v[j].y) + (v[j].z * v[j].z + v[j].w * v[j].w); }
    const float r = rsqrtf(wave_sum(s) * (1.f / D) + EPS);
    u32x2* o8 = (u32x2*)orow + lane;
#pragma unroll
    for (int j = 0; j < 4; ++j) { const int c = 4 * lane + 256 * j;
        const f32x4 g = *(const f32x4*)(gain + c), sc = *(const f32x4*)(scale + c), sh = *(const f32x4*)(shift + c);
        const f32x4 y = (v[j] * r) * g * (sc + 1.f) + sh; u32x2 w; w.x = pk2(y.x, y.y); w.y = pk2(y.z, y.w); o8[64 * j] = w; }
}
__device__ __forceinline__ void rope_cs(int tl, int lane, float& c, float& s) {
    const float fr = exp2f(-(float)(lane & 15) * (13.287712379549449f / 16.f));
    const float pos = (float)((lane >> 5) ? (tl & 63) : (tl >> 6));
    sincosf(pos * fr, &s, &c);
}
__device__ __forceinline__ float rope_apply(float w, float c, float s, int lane) {
    const float p = __shfl_xor(w, 16);
    return (lane & 16) ? (p * s + w * c) : (w * c - p * s);
}

#define XB_TMO      128
#define XB_XCNT(j)  (256  + 64 * (j))
#define XB_XSUB(j)  (1280 + 64 * (j))
#define XB_XGEN(j)  (2304 + 64 * (j))
#define XB_TOP      3328
#define XB_TOPGEN   3392
#define XCD_BAR_WORDS 3456
#define XB_SPIN_CAP (1u << 18)

__device__ __forceinline__ unsigned xb_ld(unsigned* p)              { return __hip_atomic_load(p, __ATOMIC_RELAXED, __HIP_MEMORY_SCOPE_AGENT); }
__device__ __forceinline__ unsigned xb_add(unsigned* p, unsigned v) { return __hip_atomic_fetch_add(p, v, __ATOMIC_RELAXED, __HIP_MEMORY_SCOPE_AGENT); }
__device__ __forceinline__ unsigned xb_xcc_id() { return (unsigned)__builtin_amdgcn_s_getreg((3 << 11) | 20) & 0xFu; }
#define XB_SPIN(cond, bar) do { unsigned _sp = 0; while (cond) { __builtin_amdgcn_s_sleep(1); \
    if ((++_sp & 255u) == 0u) { if (xb_ld(&(bar)[XB_TMO])) break; if (_sp > XB_SPIN_CAP) { atomicAdd(&(bar)[XB_TMO], 1u); break; } } } } while (0)

struct XcdBarrier {
    unsigned* bar; unsigned x;
    volatile LAS unsigned* st;
};

__device__ __forceinline__ XcdBarrier xcd_barrier_post(unsigned* bar, volatile LAS unsigned* st) {
    XcdBarrier b; b.bar = bar; b.x = xb_xcc_id(); b.st = st;
    if (threadIdx.x == 0) (void)xb_add(&bar[XB_XCNT(b.x)], 1u);
    return b;
}
__device__ __forceinline__ void xcd_barrier_complete(unsigned* bar, unsigned x, unsigned& nloc, unsigned& nx) {
    const unsigned G = gridDim.x * gridDim.y * gridDim.z;
    unsigned sum, cnt, mine, sp = 0u;
    for (;;) {
        sum = 0u; cnt = 0u; mine = 0u;
#pragma unroll
        for (unsigned j = 0; j < 16; ++j) { const unsigned c = xb_ld(&bar[XB_XCNT(j)]); sum += c; cnt += (c > 0u) ? 1u : 0u; mine = (j == x) ? c : mine; }
        if (sum == G) break;
        __builtin_amdgcn_s_sleep(1);
        if ((++sp & 255u) == 0u) { if (xb_ld(&bar[XB_TMO])) break; if (sp > XB_SPIN_CAP) { atomicAdd(&bar[XB_TMO], 1u); break; } }
    }
    nloc = mine > 0u ? mine : 1u; nx = cnt > 0u ? cnt : 1u;
}

__device__ __forceinline__ void xcd_barrier(const XcdBarrier& b) {
    asm volatile("s_waitcnt vmcnt(0)" ::: "memory");
    __syncthreads();
    if (threadIdx.x == 0) {
        unsigned* bar = b.bar;
        __builtin_amdgcn_s_waitcnt(0);
        unsigned nloc = b.st[0], nx = b.st[1];
        if (nloc == 0u) { xcd_barrier_complete(bar, b.x, nloc, nx); b.st[0] = nloc; b.st[1] = nx; }
        const unsigned old = xb_add(&bar[XB_XSUB(b.x)], 1u);
        const unsigned gen = old / nloc;
        if (old + 1u == (gen + 1u) * nloc) {
            __builtin_amdgcn_fence(__ATOMIC_RELEASE, "agent");
            asm volatile("s_waitcnt vmcnt(0)" ::: "memory");
            const unsigned og = xb_add(&bar[XB_TOP], 1u);
            const unsigned tg = og / nx;
            if (og + 1u == (tg + 1u) * nx) xb_add(&bar[XB_TOPGEN], 1u);
            else XB_SPIN(xb_ld(&bar[XB_TOPGEN]) == tg, bar);
            __builtin_amdgcn_fence(__ATOMIC_ACQUIRE, "agent");
            asm volatile("s_waitcnt vmcnt(0)" ::: "memory");
        } else {
            XB_SPIN(xb_ld(&bar[XB_TOPGEN]) == gen, bar);
            __builtin_amdgcn_fence(__ATOMIC_ACQUIRE, "agent");
            asm volatile("s_waitcnt vmcnt(0)" ::: "memory");
        }
    }
    __syncthreads();
}

__device__ __forceinline__ void xcd_barrier_arrive(const XcdBarrier& b) {
    asm volatile("s_waitcnt vmcnt(0)" ::: "memory");
    __syncthreads();
    if (threadIdx.x == 0) {
        unsigned* bar = b.bar;
        __builtin_amdgcn_s_waitcnt(0);
        unsigned nloc = b.st[0], nx = b.st[1];
        if (nloc == 0u) { xcd_barrier_complete(bar, b.x, nloc, nx); b.st[0] = nloc; b.st[1] = nx; }
        const unsigned old = xb_add(&bar[XB_XSUB(b.x)], 1u);
        const unsigned gen = old / nloc;
        b.st[2] = gen;
        if (old + 1u == (gen + 1u) * nloc) {
            __builtin_amdgcn_fence(__ATOMIC_RELEASE, "agent");
            asm volatile("s_waitcnt vmcnt(0)" ::: "memory");
            const unsigned og = xb_add(&bar[XB_TOP], 1u);
            const unsigned tg = og / nx;
            if (og + 1u == (tg + 1u) * nx) xb_add(&bar[XB_TOPGEN], 1u);
        }
    }
}
__device__ __forceinline__ void xcd_barrier_wait(const XcdBarrier& b) {
    if (threadIdx.x == 0) {
        unsigned* bar = b.bar; const unsigned gen = b.st[2];
        XB_SPIN(xb_ld(&bar[XB_TOPGEN]) == gen, bar);
        __builtin_amdgcn_fence(__ATOMIC_ACQUIRE, "agent");
        asm volatile("s_waitcnt vmcnt(0)" ::: "memory");
    }
    __syncthreads();
}

struct Args { const float* in[23]; float* out; unsigned char* ws; int lo, hi; };
constexpr int NPHASE = 12;

__global__ void __launch_bounds__(512, 2) mega_fwd(Args args) {
    extern __shared__ __attribute__((aligned(16))) unsigned char lds[];
    cg::grid_group grid = cg::this_grid();
    const int tid = threadIdx.x, lane = tid & 63, wave = __builtin_amdgcn_readfirstlane(tid >> 6);
    const int G = gridDim.x, bx = blockIdx.x, vcu = (G % 8 == 0) ? (bx % 8) * (G / 8) + bx / 8 : bx;
    const int gw = vcu * 8 + wave, NGW = G * 8;
    unsigned char* ws = args.ws;
    const float *x = args.in[0], *cnd = args.in[1], *ctx = args.in[2], *cctx = args.in[3], *w_mod = args.in[4], *b_mod = args.in[5], *norm_mix = args.in[6], *norm_ffn = args.in[7],
                *w_in = args.in[8], *b_gate = args.in[9], *conv_w = args.in[10], *conv_b = args.in[11], *w_conv_out = args.in[12], *q_a_norm = args.in[13], *w_q_b = args.in[14],
                *kv_a_norm = args.in[15], *w_kv_b = args.in[16], *q_norm = args.in[17], *k_norm = args.in[18], *w_attn_o = args.in[19], *w_out = args.in[20], *w_ffn_in = args.in[21], *w_ffn_out = args.in[22];
    float* MOD = (float*)(ws + WS_MOD);
    bf16_t *WIN = (bf16_t*)(ws + WS_WIN), *WC = (bf16_t*)(ws + WS_WC), *WQ = (bf16_t*)(ws + WS_WQ), *WKV = (bf16_t*)(ws + WS_WKV), *WA = (bf16_t*)(ws + WS_WA), *WO = (bf16_t*)(ws + WS_WO),
           *WF1 = (bf16_t*)(ws + WS_WF1), *WF2 = (bf16_t*)(ws + WS_WF2);
    bf16_t *XN = (bf16_t*)(ws + WS_XN), *BX = (bf16_t*)(ws + WS_BX), *QAN = (bf16_t*)(ws + WS_QAN), *KVAN = (bf16_t*)(ws + WS_KVAN), *UU = (bf16_t*)(ws + WS_UU), *QA = (bf16_t*)(ws + WS_QA),
           *KVA = (bf16_t*)(ws + WS_KVA), *Qb = (bf16_t*)(ws + WS_Q), *Hb = (bf16_t*)(ws + WS_H);
    unsigned char* Kb = ws + WS_K;
    unsigned char* Vtb = ws + WS_V;
    float *KRB = (float*)(ws + WS_KRB), *KRSS = (float*)(ws + WS_KRSS), *ROWSS = (float*)(ws + WS_ROWSS), *SHW = (float*)(ws + WS_SHW), *ROPE = (float*)(ws + WS_ROPE);
    bf16_t *SGC = (bf16_t*)args.out, *SGA = (bf16_t*)args.out + (size_t)M * D;
    bf16_t *U = XN, *Ob = XN, *HX2 = XN, *Z = BX;
    const int lo = args.lo, hi = args.hi;
#ifndef PH_MASK
#define PH_MASK 0x7FFF
#endif
#define IN(k) (((PH_MASK >> (k)) & 1) && lo <= (k) && (k) < hi)
#ifndef DUP_MASK
#define DUP_MASK 0
#endif
#define REP(k) for (int rep_ = 0; rep_ < (((DUP_MASK >> (k)) & 1) ? 2 : 1); ++rep_)
#ifndef MK_CG_SEAM0
#define MK_CG_SEAM0 0
#endif
#define SEAM2(k, k2) do { if (IN(k) && IN(k2)) xcd_barrier(xbar); } while (0)
#define SEAM(k) do { if (IN(k) && IN((k) + 1)) { if ((k) == 0 && MK_CG_SEAM0) grid.sync(); else xcd_barrier(xbar); } } while (0)
    LAS unsigned char* ldsl = (LAS unsigned char*)lds;
    constexpr int CI_C = 16 * 32, CI_Q = (QL / 64) * (1536 / 32), CI_KV = (KVL / 64) * (2048 / 32), CI_F1 = 16 * (2 * DFF / 32), CI_F2 = (DFF / 64) * 32;
    constexpr int CO_Q = CI_C, CO_KV = CO_Q + CI_Q, CO_A = CO_KV + CI_KV, CO_O = CO_A + CI_C, CO_F1 = CO_O + CI_C, CO_F2 = CO_F1 + CI_F1, CO_END = CO_F2 + CI_F2;
#define CONV(lo_, hi_) do { LAS float* scr_ = (LAS float*)(ldsl + wave * 16384); for (int it_ = (lo_) + gw; it_ < (hi_); it_ += NGW) { \
        if (it_ < CO_Q) transpose_item(w_conv_out, D, D, WC, MAP_ID, scr_, it_, lane); \
        else if (it_ < CO_KV) transpose_item(w_q_b, QL, 1536, WQ, MAP_ID, scr_, it_ - CO_Q, lane); \
        else if (it_ < CO_A) transpose_item(w_kv_b, KVL, 2048, WKV, MAP_KV, scr_, it_ - CO_KV, lane); \
        else if (it_ < CO_O) transpose_item(w_attn_o, D, D, WA, MAP_ID, scr_, it_ - CO_A, lane); \
        else if (it_ < CO_F1) transpose_item(w_out, D, D, WO, MAP_ID, scr_, it_ - CO_O, lane); \
        else if (it_ < CO_F2) transpose_item(w_ffn_in, D, 2 * DFF, WF1, MAP_FF1, scr_, it_ - CO_F1, lane); \
        else transpose_item(w_ffn_out, DFF, D, WF2, MAP_ID, scr_, it_ - CO_F2, lane); } } while (0)
#define SEAMW(work_) do { xcd_barrier_arrive(xbar); work_; xcd_barrier_wait(xbar); } while (0)
    volatile LAS unsigned* xst = (volatile LAS unsigned*)(ldsl + LDS_BYTES - 64);
    if (tid < 2) xst[tid] = 0u;
    __syncthreads();
    XcdBarrier xbar = xcd_barrier_post((unsigned*)(ws + WS_BAR), xst);
    if (args.ws == nullptr) grid.sync();

#ifdef EXTRA_SYNCS
    for (int i_ = 0; i_ < EXTRA_SYNCS; ++i_) grid.sync();
#endif
    if (IN(0)) {
        for (int cb = bx; cb < 256; cb += G) {
            LAS float* red = (LAS float*)ldsl;
            if (tid < 510) { const int q = tid % 6, ks = tid / 6; const float* wp = w_mod + cb * 24 + q * 4;
                f32x4 a0 = {0.f, 0.f, 0.f, 0.f}, a1 = a0, a2 = a0;
#pragma unroll 13
                for (int k = ks; k < D; k += 85) { const f32x4 w = *(const f32x4*)(wp + (size_t)k * 6144);
                    const float s0 = siluf_(cnd[k]), s1 = siluf_(cnd[D + k]), s2 = siluf_(cctx[k]); a0 += w * s0; a1 += w * s1; a2 += w * s2; }
#pragma unroll
                for (int i = 0; i < 4; ++i) { red[tid * 12 + i] = a0[i]; red[tid * 12 + 4 + i] = a1[i]; red[tid * 12 + 8 + i] = a2[i]; } }
            __syncthreads();
            if (tid < 72) { const int cond = tid / 24, c = tid % 24, q = c >> 2, e = c & 3; float sacc = 0.f;
                for (int ks = 0; ks < 85; ++ks) sacc += red[(ks * 6 + q) * 12 + cond * 4 + e];
                MOD[cond * 6144 + cb * 24 + c] = sacc + b_mod[cb * 24 + c]; }
            __syncthreads();
        }
        xcd_barrier_arrive(xbar);
        LAS float* scr = (LAS float*)(ldsl + wave * 16384);
        constexpr int I_IN = 16 * (DIN / 32), I_C = 16 * 32, I_Q = (QL / 64) * (1536 / 32), I_KV = (KVL / 64) * (2048 / 32), I_F1 = 16 * (2 * DFF / 32), I_F2 = (DFF / 64) * 32;
        for (int it = gw; it < I_IN; it += NGW) transpose_item(w_in, D, DIN, WIN, MAP_WIN, scr, it, lane);
        (void)I_C; (void)I_Q; (void)I_KV; (void)I_F1; (void)I_F2;
        for (int i = bx * 512 + tid; i < 64 * D / 8; i += G * 512) *(u32x4*)(WIN + (size_t)3776 * D + (size_t)i * 8) = (u32x4){0u, 0u, 0u, 0u};
    }
    xcd_barrier_wait(xbar);
    if (IN(1)) REP(1) {
#pragma unroll 2
        for (int row = gw; row < MT; row += NGW) {
            const float* src = row < M ? x + (size_t)row * D : ctx + (size_t)(row - M) * D;
            const float* md = MOD + (row < M ? (row >> 13) : 2) * 6144;
            norm_mod_row(src, norm_mix, md, md + D, XN + (size_t)row * D, lane);
        }
        xcd_barrier_arrive(xbar);
        CONV(0, CO_A);
        for (int t = gw; t < SEQ; t += NGW) {
            const int jj = lane & 31; const float fr = exp2f(-(float)(jj & 15) * (13.287712379549449f / 16.f)); const float pos = (float)((jj >> 4) ? (t & 63) : (t >> 6));
            float sn, cs; sincosf(pos * fr, &sn, &cs); ROPE[(size_t)t * 64 + lane] = lane < 32 ? cs : sn; }
    }
    xcd_barrier_wait(xbar);
    if (IN(2)) REP(2) {
        pg8::Gemm g{XN, WIN, MT, DINP, D}; pg8::StaticOrder S; S.init(MT, DINP, G, bx);
        Epi8<FIn> E{{BX, UU, QA, KVA, SGC, SGA, b_gate}};
        pg8::gemm_phase<Epi8<FIn>, pg8::StaticOrder, true, true>(ldsl, g, S, E);
    }
    SEAMW(CONV(CO_A, CO_F1));
    if (IN(3)) REP(3) {
        for (int row = gw; row < MT; row += NGW) {
            const int tl = row & (SEQ - 1); const bool lat = row < M;
            const size_t o0 = (size_t)row * D + lane * 8, o1 = o0 + 512; const u32x4 z4 = {0u, 0u, 0u, 0u};
            u32x4 lb0 = z4, lb1 = z4, lu0 = z4, lu1 = z4, lm0 = z4, lm1 = z4, lp0 = z4, lp1 = z4, lq = z4, lk = z4;
            if (lat) { lb0 = *(const u32x4*)(BX + o0); lb1 = *(const u32x4*)(BX + o1); lu0 = *(const u32x4*)(UU + o0); lu1 = *(const u32x4*)(UU + o1);
                if (tl > 0) { lm0 = *(const u32x4*)(UU + o0 - D); lm1 = *(const u32x4*)(UU + o1 - D); }
                if (tl < SEQ - 1) { lp0 = *(const u32x4*)(UU + o0 + D); lp1 = *(const u32x4*)(UU + o1 + D); }
                if (lane < 48) lq = *(const u32x4*)(QA + (size_t)row * QL + lane * 8); }
            if (lane < 32) lk = *(const u32x4*)(KVA + (size_t)row * 320 + lane * 8);
            const float kr = bf1(KVA[(size_t)row * 320 + 256 + lane]);
            float rc = 1.f, rs = 0.f; if (lat) { const float* rt = ROPE + (size_t)tl * 64 + (lane >> 5) * 16 + (lane & 15); rc = rt[0]; rs = rt[32]; }
            if (lat) {
#pragma unroll
                for (int j = 0; j < 2; ++j) { const int c = lane * 8 + 512 * j;
                    float bb[8], um[8], u0[8], up[8], r[8];
                    unpack8(j ? lb1 : lb0, bb); unpack8(j ? lu1 : lu0, u0); unpack8(j ? lm1 : lm0, um); unpack8(j ? lp1 : lp0, up);
#pragma unroll
                    for (int i = 0; i < 8; ++i) r[i] = bb[i] * (conv_w[c + i] * um[i] + conv_w[D + c + i] * u0[i] + conv_w[2 * D + c + i] * up[i] + conv_b[c + i]);
                    *(u32x4*)(U + (j ? o1 : o0)) = pack8(r); }
                float q[8]; float ss = 0.f; unpack8(lq, q);
#pragma unroll
                for (int i = 0; i < 8; ++i) ss += q[i] * q[i];
                const float rq = rsqrtf(wave_sum(ss) * (1.f / QL) + EPS);
                if (lane < 48) {
#pragma unroll
                    for (int i = 0; i < 8; ++i) q[i] = q[i] * rq * q_a_norm[lane * 8 + i];
                    *(u32x4*)(QAN + (size_t)row * QL + lane * 8) = pack8(q); }
            }
            { float q[8]; float ss = 0.f; unpack8(lk, q);
#pragma unroll
              for (int i = 0; i < 8; ++i) ss += q[i] * q[i];
              const float rk = rsqrtf(wave_sum(ss) * (1.f / KVL) + EPS);
              if (lane < 32) {
#pragma unroll
                  for (int i = 0; i < 8; ++i) q[i] = q[i] * rk * kv_a_norm[lane * 8 + i];
                  *(u32x4*)(KVAN + (size_t)row * KVL + lane * 8) = pack8(q); } }
            { const float krss = wave_sum(kr * kr); float w = kr * k_norm[128 + lane];
              if (lat) w = rope_apply(w, rc, rs, lane);
              KRB[(size_t)row * 64 + lane] = w; if (lane == 0) KRSS[row] = krss; }
        }
    }
    SEAMW(CONV(CO_F1, CO_F1 + CI_F1 / 2));
    if (IN(4)) REP(4) {
        if ((PH_MASK >> 12) & 1) { pg8::Gemm g{U, WC, M, D, D}; pg8::StaticOrder S; S.init(M, D, G, bx); Epi8<FConv> E{{SGC, Z}};
          pg8::gemm_phase<Epi8<FConv>, pg8::StaticOrder, true, true>(ldsl, g, S, E); }
        if ((PH_MASK >> 13) & 1) { int kq = QL; asm volatile("" : "+s"(kq)); pg8::Gemm g{QAN, WQ, M, 1536, kq}; pg8::StaticOrder S; S.init(M, 1536, G, bx); Epi8<FQ> E{{Qb}};
          pg8::gemm_phase<Epi8<FQ>, pg8::StaticOrder, true, true>(ldsl, g, S, E); }
        if ((PH_MASK >> 14) & 1) { int kkv = KVL; asm volatile("" : "+s"(kkv)); pg8::Gemm g{KVAN, WKV, MT, D, kkv}; pg8::StaticOrder S; S.init(MT, D, G, (bx + G / 2) % G); EpiK2 E{Kb, KRB, KRSS, k_norm, (LAS float*)(ldsl + 131072 + 1024)};
          pg8::gemm_phase<EpiK2, pg8::StaticOrder, true, true>(ldsl, g, S, E); }
        if ((PH_MASK >> 14) & 1) { int kkv = KVL; asm volatile("" : "+s"(kkv)); pg8::Gemm g{WKV + (size_t)D * KVL, KVAN, D, MT, kkv}; pg8::StaticOrder S; S.init(D, MT, G, (bx + G / 4) % G); Epi8<FVt> E{{Vtb}};
          pg8::gemm_phase<Epi8<FVt>, pg8::StaticOrder, true, true>(ldsl, g, S, E); }
    }
    SEAMW(CONV(CO_F1 + CI_F1 / 2, CO_F2));
    if (IN(6)) REP(6) {
        for (int L = vcu; L < 2 * NH * (SEQ / 256); L += G) {
            const int bh = L >> 5, qb = L & 31, b = bh >> 3, h = bh & 7;
            att::attn_unit(Qb + ((size_t)b * SEQ + qb * 256) * 1536 + h * DK, Kb + (size_t)bh * SKV * DK, Vtb + (size_t)bh * SKV * DV,
                           Ob + ((size_t)b * SEQ + qb * 256) * D + h * DV, (char*)lds, ldsl, q_norm, ROPE, qb * 256);
        }
    }
    SEAMW(CONV(CO_F2, CO_END));
    if (IN(7)) {
        pg8::Gemm g{Ob, WA, M, D, D}; pg8::StaticOrder S; S.init(M, D, G, bx); Epi8<FAo> E{{SGA, Z}};
        pg8::gemm_phase<Epi8<FAo>, pg8::StaticOrder, true, true>(ldsl, g, S, E);
    }
    xcd_barrier_arrive(xbar);
    {
        for (int n = gw; n < 2 * DFF; n += NGW) {
            float w0[8], w1[8]; unpack8(*(const u32x4*)(WF1 + (size_t)n * D + lane * 8), w0); unpack8(*(const u32x4*)(WF1 + (size_t)n * D + 512 + lane * 8), w1);
            const float* s0 = MOD + 3 * D + lane * 8; const float* s1 = s0 + 6144; float d0 = 0.f, d1 = 0.f;
#pragma unroll
            for (int i = 0; i < 8; ++i) { d0 += w0[i] * s0[i] + w1[i] * s0[512 + i]; d1 += w0[i] * s1[i] + w1[i] * s1[512 + i]; }
            d0 = wave_sum(d0); d1 = wave_sum(d1); if (lane == 0) { SHW[n] = d0; SHW[2 * DFF + n] = d1; } }
    }
    xcd_barrier_wait(xbar);
    if (IN(8)) {
        pg8::Gemm g{Z, WO, M, D, D}; pg8::StaticOrder S; S.init(M, D, G, bx); Epi8<FRes2> E{{x, args.out, MOD, norm_ffn, HX2, ROWSS}};
        pg8::gemm_phase<Epi8<FRes2>, pg8::StaticOrder, true, true>(ldsl, g, S, E);
    }
    SEAM2(8, 10);
    if (IN(10)) REP(10) {
        pg8::Gemm g{HX2, WF1, M, 2 * DFF, D}; pg8::StaticOrder S; S.init(M, 2 * DFF, G, bx); Epi8<FFfn1> E{{Hb, ROWSS, SHW}};
        pg8::gemm_phase<Epi8<FFfn1>, pg8::StaticOrder, true, true>(ldsl, g, S, E);
    }
    SEAM(10);
    if (IN(11)) {
        pg8::Gemm g{Hb, WF2, M, D, DFF}; pg8::StaticOrder S; S.init(M, D, G, bx); Epi8<FRes> E{{args.out, args.out, MOD + 5 * D}};
        pg8::gemm_phase<Epi8<FRes>, pg8::StaticOrder, true, true>(ldsl, g, S, E);
    }
#undef IN
#undef SEAM
#undef SEAM2
}

#ifndef MK_PER_PHASE
#define MK_PER_PHASE 0
#endif
extern "C" void kernel_launch(void* const* d_in, const int* in_sizes, int n_in, void* d_out, int out_size, void* d_ws, size_t ws_size, hipStream_t stream) {
    static int grid = 0;
    if (grid == 0) {
        if (n_in != 23 || out_size != M * D || ws_size < WS_END) { fprintf(stderr, "kernel_launch: unexpected shapes n_in %d out %d ws %zu (need %zu)\n", n_in, out_size, ws_size, (size_t)WS_END); grid = -1; return; }
        int dev = 0, cus = 0, per_cu = 0;
        hipGetDevice(&dev); hipDeviceGetAttribute(&cus, hipDeviceAttributeMultiprocessorCount, dev);
        if (hipFuncSetAttribute((const void*)mega_fwd, hipFuncAttributeMaxDynamicSharedMemorySize, LDS_BYTES) != hipSuccess) { fprintf(stderr, "kernel_launch: hipFuncSetAttribute failed\n"); grid = -1; return; }
        if (hipOccupancyMaxActiveBlocksPerMultiprocessor(&per_cu, (const void*)mega_fwd, 512, LDS_BYTES) != hipSuccess || per_cu < 1) { fprintf(stderr, "kernel_launch: occupancy query says %d\n", per_cu); (void)hipGetLastError(); grid = -1; return; }
        grid = cus * per_cu; if (grid > 256) grid = 256;
        fprintf(stderr, "kernel_launch: grid %d (cus %d x %d)\n", grid, cus, per_cu);
    }
    if (grid < 0) return;
    (void)hipMemsetAsync((char*)d_ws + WS_MOD, 0, CTL_BYTES, stream);
    Args a{};
    for (int i = 0; i < 23; ++i) a.in[i] = (const float*)d_in[i];
    a.out = (float*)d_out; a.ws = (unsigned char*)d_ws;
#if MK_PER_PHASE
    for (int p = 0; p < NPHASE; ++p) { a.lo = p; a.hi = p + 1; hipLaunchKernelGGL(mega_fwd, dim3(grid), dim3(512), LDS_BYTES, stream, a); }
#else
    a.lo = 0; a.hi = NPHASE;
    void* kargs[] = {&a};
    hipError_t e = hipLaunchCooperativeKernel((const void*)mega_fwd, dim3(grid), dim3(512), kargs, LDS_BYTES, stream);
    if (e != hipSuccess) fprintf(stderr, "kernel_launch: cooperative launch failed: %s (grid %d)\n", hipGetErrorString(e), grid);
#endif
}
```

```cpp
#include <hip/hip_runtime.h>
#include <hip/hip_cooperative_groups.h>
#include <cstdio>
#include <cstdint>
namespace cg = cooperative_groups;
namespace pg8 {
#define PG8_LAS __attribute__((address_space(3)))
typedef unsigned short bf16_t;
typedef short bf16x8 __attribute__((ext_vector_type(8)));
typedef float f32x4 __attribute__((ext_vector_type(4)));
typedef unsigned u32x4 __attribute__((ext_vector_type(4)));
constexpr int BM = 256, BK = 64, HALF = 128, HTB = HALF * BK * 2  , STAGE_BYTES = 8 * HTB, NXCD = 8, WGM = 8;

__host__ __device__ __forceinline__ int lds_byte(int r, int c) { const int st = (r >> 4) * 2 + (c >> 5), rr = r & 15, cc = c & 31, ob = rr * 64 + cc * 2; return st * 1024 + (ob ^ (((ob >> 9) & 1) << 5)); }
__host__ __device__ __forceinline__ void stage_rc(int b, int& R, int& C) { const int st = b / 1024, sb = b % 1024, swz = sb ^ (((sb >> 9) & 1) << 5); R = (st >> 1) * 16 + swz / 64; C = (st & 1) * 32 + (swz % 64) / 2; }
__host__ __device__ __forceinline__ int perm32(int rho) { const int n = rho >> 4, i = rho & 15; return 8 * (i >> 2) + 4 * n + (i & 3); }

struct Unit { int pm, pn; };
struct Gemm { const bf16_t* A; const bf16_t* Bt; int M, N, K; };

struct StaticOrder {
    int nM, nN, nwg, G, c;
    __host__ __device__ void init(int M, int N, int G_, int c_) { nM = M / BM; nN = N / BM; nwg = nM * nN; G = G_; c = c_; }
    __host__ __device__ bool next(int i, Unit& u) const {
        const long L = (long)i * G + c; if (L >= nwg) return false;
        int wgid = (int)L; { const int q = nwg / NXCD, r = nwg % NXCD, xcd = wgid % NXCD, off = wgid / NXCD; wgid = (xcd < r ? xcd * (q + 1) : r * (q + 1) + (xcd - r) * q) + off; }
        const int nig = WGM * nN, gid = wgid / nig, fm = gid * WGM, gsz = (nM - fm) < WGM ? (nM - fm) : WGM;
        u.pm = fm + ((wgid % nig) % gsz); u.pn = (wgid % nig) / gsz; return true;
    }
    __device__ __forceinline__ void a_ready(const Unit&) const {}
    __device__ __forceinline__ void done(const Unit&) const {}
};
__device__ __forceinline__ unsigned cvt_pk_bf16(float lo, float hi) { unsigned r; asm volatile("v_cvt_pk_bf16_f32 %0, %1, %2" : "=v"(r) : "v"(lo), "v"(hi)); return r; }
template <class Epi, class Sched, bool ALIGN_EPI = false, bool SP2 = false>
__device__ __forceinline__ void gemm_phase(PG8_LAS unsigned char* lds, const Gemm g, const Sched& S, const Epi& E) {
    int tid_ = threadIdx.x; asm volatile("" : "+v"(tid_));
    const int tid = tid_, wid = __builtin_amdgcn_readfirstlane(tid >> 6), lane = tid & 63, wr = wid >> 2, wc = wid & 3, fr = lane & 15, fq = lane >> 4;
    const int K = g.K, nt = K / BK;
    unsigned voffA[2], voffB[2];
#pragma unroll
    for (int i = 0; i < 2; ++i) { int R, C; stage_rc(tid * 16 + i * 8192, R, C); const int Rb = Epi::PERM ? ((R & ~31) + perm32(R & 31)) : R;
        voffA[i] = (unsigned)(R * K + C) * 2u; voffB[i] = (unsigned)(Rb * K + C) * 2u; }
    const size_t kstep = (size_t)(BK * 2);
    const size_t hstep = (size_t)HALF * K * 2;
    const size_t tstep = 2 * hstep;
    const unsigned ldsw = (unsigned)wid * 1024u;
    const int aoff = lds_byte(wr * 64 + fr, fq * 8), boff = lds_byte(wc * 32 + fr, fq * 8);
#define PG8_SA(b, h) (((b) * 2 + (h)) * HTB)
#define PG8_SB(b, h) ((4 + (b) * 2 + (h)) * HTB)
#define PG8_STAGE(bufoff, gbase, voff) do { _Pragma("unroll") for (int _i = 0; _i < 2; ++_i) \
        __builtin_amdgcn_global_load_lds((const unsigned*)((const char*)(gbase) + (voff)[_i]), (PG8_LAS unsigned*)(lds + (bufoff) + ldsw + _i * 8192), 16, 0, 0); } while (0)
#define PG8_LDA(dst, b, h) do { _Pragma("unroll") for (int m = 0; m < 4; ++m) _Pragma("unroll") for (int k = 0; k < 2; ++k) dst[m][k] = *(const PG8_LAS bf16x8*)(lds + PG8_SA(b, h) + aoff + m * 2048 + k * 1024); } while (0)
#define PG8_LDB(dst, b, h) do { _Pragma("unroll") for (int n = 0; n < 2; ++n) _Pragma("unroll") for (int k = 0; k < 2; ++k) dst[n][k] = *(const PG8_LAS bf16x8*)(lds + PG8_SB(b, h) + boff + n * 2048 + k * 1024); } while (0)
#define PG8_MMA(ai, bj, At, Bt) do { __builtin_amdgcn_s_setprio(1); _Pragma("unroll") for (int m = 0; m < 4; ++m) _Pragma("unroll") for (int n = 0; n < 2; ++n) _Pragma("unroll") for (int k = 0; k < 2; ++k) \
        acc[ai][bj][m][n] = __builtin_amdgcn_mfma_f32_16x16x32_bf16(Bt[n][k], At[m][k], acc[ai][bj][m][n], 0, 0, 0); __builtin_amdgcn_s_setprio(0); } while (0)
#define PG8_WAIT_V(n) asm volatile("s_waitcnt vmcnt(" #n ")" ::: "memory")
#define PG8_WAIT_L(n) asm volatile("s_waitcnt lgkmcnt(" #n ")" ::: "memory")
#define PG8_BAR __builtin_amdgcn_s_barrier()
#define PG8_SCHED __builtin_amdgcn_sched_barrier(0)
    Unit cur, nxt; int ui = 0;
    if (!S.next(0, cur)) return;
    f32x4 acc[2][2][4][2];
#pragma unroll
    for (int a = 0; a < 2; ++a)
#pragma unroll
        for (int b = 0; b < 2; ++b)
#pragma unroll
            for (int m = 0; m < 4; ++m)
#pragma unroll
                for (int n = 0; n < 2; ++n) acc[a][b][m][n] = (f32x4){0.f, 0.f, 0.f, 0.f};
    bf16x8 At[4][2], B0[2][2], B1[2][2];
    const char* cA = (const char*)g.A + (size_t)cur.pm * tstep; const char* cB = (const char*)g.Bt + (size_t)cur.pn * tstep;
    S.a_ready(cur);
    if constexpr (SP2) {
        PG8_STAGE(PG8_SB(0, 0), cB, voffB); PG8_STAGE(PG8_SB(0, 1), cB + hstep, voffB); PG8_STAGE(PG8_SA(0, 0), cA, voffA); PG8_STAGE(PG8_SA(0, 1), cA + hstep, voffA);
        if (wr == 1) PG8_BAR;
        PG8_WAIT_V(2); PG8_BAR;
        PG8_STAGE(PG8_SB(1, 0), cB + kstep, voffB); PG8_STAGE(PG8_SA(1, 0), cA + kstep, voffA); PG8_STAGE(PG8_SB(1, 1), cB + hstep + kstep, voffB);
        PG8_WAIT_V(6); PG8_BAR;
    } else {
        PG8_STAGE(PG8_SB(0, 0), cB, voffB); PG8_STAGE(PG8_SA(0, 0), cA, voffA); PG8_STAGE(PG8_SB(0, 1), cB + hstep, voffB); PG8_STAGE(PG8_SA(0, 1), cA + hstep, voffA);
        if (wr == 1) PG8_BAR;
        PG8_WAIT_V(4); PG8_BAR;
        PG8_STAGE(PG8_SB(1, 0), cB + kstep, voffB); PG8_STAGE(PG8_SA(1, 0), cA + kstep, voffA); PG8_STAGE(PG8_SB(1, 1), cB + hstep + kstep, voffB);
        PG8_WAIT_V(6); PG8_BAR;
    }
    for (;;) {
        const bool has_next = S.next(ui + 1, nxt);
        const char* nA = has_next ? (const char*)g.A + (size_t)nxt.pm * tstep : cA; const char* nB = has_next ? (const char*)g.Bt + (size_t)nxt.pn * tstep : cB;
        for (int t = 0; t < nt; t += 2) {
            const bool last = (t == nt - 2);
            const char* a1 = cA + (size_t)(t + 1) * kstep;
            const char* a2 = last ? nA : cA + (size_t)(t + 2) * kstep; const char* b2 = last ? nB : cB + (size_t)(t + 2) * kstep;
            const char* a3 = a2 + kstep; const char* b3 = b2 + kstep;
            if (last && has_next) S.a_ready(nxt);
            if constexpr (SP2) {
            PG8_LDB(B0, 0, 0); PG8_LDB(B1, 0, 1); PG8_SCHED; PG8_LDA(At, 0, 0); PG8_STAGE(PG8_SA(1, 1), a1 + hstep, voffA);
            PG8_WAIT_V(8); PG8_WAIT_L(0); PG8_BAR; PG8_MMA(0, 0, At, B0); PG8_MMA(0, 1, At, B1); PG8_BAR; PG8_SCHED;
            PG8_LDA(At, 0, 1); PG8_STAGE(PG8_SB(0, 0), b2, voffB); PG8_STAGE(PG8_SB(0, 1), b2 + hstep, voffB); PG8_STAGE(PG8_SA(0, 0), a2, voffA);
            PG8_WAIT_V(8); PG8_WAIT_L(0); PG8_BAR; PG8_MMA(1, 0, At, B0); PG8_MMA(1, 1, At, B1); PG8_BAR; PG8_SCHED;
            PG8_LDB(B0, 1, 0); PG8_LDB(B1, 1, 1); PG8_SCHED; PG8_LDA(At, 1, 0); PG8_STAGE(PG8_SA(0, 1), a2 + hstep, voffA);
            PG8_WAIT_V(8); PG8_WAIT_L(0); PG8_BAR; PG8_MMA(0, 0, At, B0); PG8_MMA(0, 1, At, B1); PG8_BAR; PG8_SCHED;
            PG8_LDA(At, 1, 1); PG8_STAGE(PG8_SB(1, 0), b3, voffB); PG8_STAGE(PG8_SB(1, 1), b3 + hstep, voffB); PG8_STAGE(PG8_SA(1, 0), a3, voffA);
            PG8_WAIT_V(8); PG8_WAIT_L(0); PG8_BAR; PG8_MMA(1, 0, At, B0); PG8_MMA(1, 1, At, B1); PG8_BAR; PG8_SCHED;
            } else {
            PG8_LDB(B0, 0, 0); PG8_SCHED; PG8_LDA(At, 0, 0); PG8_STAGE(PG8_SA(1, 1), a1 + hstep, voffA);
            PG8_WAIT_L(8); PG8_BAR; PG8_WAIT_L(0); PG8_MMA(0, 0, At, B0); PG8_BAR; PG8_SCHED;
            PG8_LDB(B1, 0, 1); PG8_STAGE(PG8_SB(0, 0), b2, voffB);
            PG8_BAR; PG8_WAIT_L(0); PG8_MMA(0, 1, At, B1); PG8_BAR;
            PG8_LDA(At, 0, 1); PG8_STAGE(PG8_SA(0, 0), a2, voffA);
            PG8_BAR; PG8_WAIT_L(0); PG8_MMA(1, 0, At, B0); PG8_BAR; PG8_SCHED;
            PG8_STAGE(PG8_SB(0, 1), b2 + hstep, voffB);
            PG8_WAIT_V(6); PG8_BAR; PG8_MMA(1, 1, At, B1); PG8_BAR;
            PG8_LDB(B0, 1, 0); PG8_SCHED; PG8_LDA(At, 1, 0); PG8_STAGE(PG8_SA(0, 1), a2 + hstep, voffA);
            PG8_WAIT_L(8); PG8_BAR; PG8_WAIT_L(0); PG8_MMA(0, 0, At, B0); PG8_BAR; PG8_SCHED;
            PG8_LDB(B1, 1, 1); PG8_STAGE(PG8_SB(1, 0), b3, voffB);
            PG8_BAR; PG8_WAIT_L(0); PG8_MMA(0, 1, At, B1); PG8_BAR;
            PG8_LDA(At, 1, 1); PG8_STAGE(PG8_SA(1, 0), a3, voffA);
            PG8_BAR; PG8_WAIT_L(0); PG8_MMA(1, 0, At, B0); PG8_BAR; PG8_SCHED;
            PG8_STAGE(PG8_SB(1, 1), b3 + hstep, voffB);
            PG8_WAIT_V(6); PG8_BAR; PG8_MMA(1, 1, At, B1); PG8_BAR;
            }
        }
        if constexpr (ALIGN_EPI) { if (wr == 0) PG8_BAR; }
        if constexpr (!Epi::AFTER_DRAIN) { E(acc, cur, wr, wc, fr, fq); S.done(cur); }
        if (!has_next) break;
#pragma unroll
        for (int a = 0; a < 2; ++a)
#pragma unroll
            for (int b = 0; b < 2; ++b)
#pragma unroll
                for (int m = 0; m < 4; ++m)
#pragma unroll
                    for (int n = 0; n < 2; ++n) acc[a][b][m][n] = (f32x4){0.f, 0.f, 0.f, 0.f};
        cur = nxt; cA = nA; cB = nB; ++ui;
        if constexpr (ALIGN_EPI) { if (wr == 1) PG8_BAR; }
    }
    PG8_WAIT_V(0);
    if constexpr (!ALIGN_EPI) { if (wr == 0) PG8_BAR; }
    PG8_BAR;
    if constexpr (Epi::AFTER_DRAIN) { E.fused(acc, cur, wr, wc, fr, fq, lds, wid, lane); S.done(cur); }
#undef PG8_SA
#undef PG8_SB
#undef PG8_STAGE
#undef PG8_LDA
#undef PG8_LDB
#undef PG8_MMA
#undef PG8_WAIT_V
#undef PG8_WAIT_L
#undef PG8_BAR
#undef PG8_SCHED
}
}

constexpr int D = 1024, SEQ = 8192, M = 16384, CTXL = 256, MC = 512, MT = M + MC;
constexpr int NH = 8, DK = 192, DV = 128, QL = 384, KVL = 256, DIN = 5824, DINP = 5888, DFF = 2816, SKV = SEQ + CTXL;
constexpr float EPS = 1e-6f;
typedef unsigned short bf16_t;
typedef float f32x4 __attribute__((ext_vector_type(4)));
typedef unsigned u32x4 __attribute__((ext_vector_type(4)));
typedef unsigned u32x2 __attribute__((ext_vector_type(2)));
#define LAS __attribute__((address_space(3)))

constexpr size_t WS_MOD = 0;
constexpr size_t MOD_BYTES = 3 * 6144 * 4;
constexpr size_t WS_BAR = 81920, WS_ROWSS = 131072, CTL_BYTES = 131072 + 65536;
constexpr size_t WS_SHW = CTL_BYTES;
constexpr size_t WS_ROPE = WS_SHW + 65536;
constexpr size_t WS_WIN = WS_ROPE + (size_t)SEQ * 64 * 4;
constexpr size_t WS_KRB = WS_WIN;
constexpr size_t WS_KRSS = WS_KRB + (size_t)MT * 64 * 4;
constexpr size_t WS_WC = WS_WIN + (size_t)DINP * D * 2;
constexpr size_t WS_WQ = WS_WC + (size_t)D * D * 2;
constexpr size_t WS_WKV = WS_WQ + (size_t)1536 * QL * 2;
constexpr size_t WS_WA = WS_WKV + (size_t)2048 * KVL * 2;
constexpr size_t WS_WO = WS_WA + (size_t)D * D * 2;
constexpr size_t WS_WF1 = WS_WO + (size_t)D * D * 2;
constexpr size_t WS_WF2 = WS_WF1 + (size_t)2 * DFF * D * 2;
constexpr size_t WS_XN = WS_WF2 + (size_t)D * DFF * 2;
constexpr size_t WS_BX = WS_XN + (size_t)MT * D * 2;
constexpr size_t WS_QAN = WS_BX + (size_t)M * D * 2;
constexpr size_t WS_KVAN = WS_QAN + (size_t)M * QL * 2;
constexpr size_t WS_R = WS_KVAN + (size_t)MT * KVL * 2;
constexpr size_t WS_UU = WS_R;
constexpr size_t WS_QA = WS_UU + (size_t)M * D * 2;
constexpr size_t WS_KVA = WS_QA + (size_t)M * QL * 2;
constexpr size_t WS_Q = WS_R;
constexpr size_t WS_K = WS_Q + (size_t)M * 1536 * 2;
constexpr size_t WS_V = WS_K + (size_t)2 * NH * SKV * DK * 2;
constexpr size_t WS_H = WS_R;
constexpr size_t WS_END = WS_V + (size_t)2 * NH * SKV * DV * 2;
static_assert(WS_END <= 268435456ull, "d_ws map exceeds 256 MiB");
static_assert(WS_KVA + (size_t)MT * 320 * 2 <= WS_END && WS_H + (size_t)M * DFF * 2 <= WS_END, "overlay");
static_assert(WS_KRSS + (size_t)MT * 4 <= WS_WC, "KRB overlay");

constexpr int LDS_BYTES = 140 * 1024;

__device__ __forceinline__ unsigned pk2(float lo, float hi) { return pg8::cvt_pk_bf16(lo, hi); }
__device__ __forceinline__ float bflo(unsigned w) { return __uint_as_float(w << 16); }
__device__ __forceinline__ float bfhi(unsigned w) { return __uint_as_float(w & 0xffff0000u); }
__device__ __forceinline__ float bf1(bf16_t h) { return __uint_as_float(((unsigned)h) << 16); }
__device__ __forceinline__ bf16_t f2bf1(float f) { return (bf16_t)(pk2(f, f) & 0xffffu); }
__device__ __forceinline__ void unpack8(u32x4 w, float* v) {
    v[0] = bflo(w.x); v[1] = bfhi(w.x); v[2] = bflo(w.y); v[3] = bfhi(w.y); v[4] = bflo(w.z); v[5] = bfhi(w.z); v[6] = bflo(w.w); v[7] = bfhi(w.w);
}
__device__ __forceinline__ u32x4 pack8(const float* v) { u32x4 w; w.x = pk2(v[0], v[1]); w.y = pk2(v[2], v[3]); w.z = pk2(v[4], v[5]); w.w = pk2(v[6], v[7]); return w; }
__device__ __forceinline__ u32x4 pack8v(f32x4 a, f32x4 b) { u32x4 w; w.x = pk2(a[0], a[1]); w.y = pk2(a[2], a[3]); w.z = pk2(b[0], b[1]); w.w = pk2(b[2], b[3]); return w; }
__device__ __forceinline__ unsigned pk4_fp8(float a, float b, float c, float d) { int w = 0; w = __builtin_amdgcn_cvt_pk_fp8_f32(a, b, w, false); w = __builtin_amdgcn_cvt_pk_fp8_f32(c, d, w, true); return (unsigned)w; }
__device__ __forceinline__ float wave_sum(float v) {
#pragma unroll
    for (int o = 1; o < 64; o <<= 1) v += __shfl_xor(v, o);
    return v;
}
__device__ __forceinline__ float sigmoidf_(float x) { return __builtin_amdgcn_rcpf(1.f + __expf(-x)); }
__device__ __forceinline__ float siluf_(float x) { return x * sigmoidf_(x); }

template <class F> struct Epi8 {
    static constexpr bool PERM = true, AFTER_DRAIN = false;
    F f;
    __device__ __forceinline__ void operator()(const pg8::f32x4 (&acc)[2][2][4][2], const pg8::Unit& u, int wr, int wc, int fr, int fq) const {
        const int cl = wc * 32 + 8 * fq;
#pragma unroll
        for (int ai = 0; ai < 2; ++ai)
#pragma unroll
            for (int m = 0; m < 4; ++m) {
                const int row = u.pm * 256 + ai * 128 + wr * 64 + m * 16 + fr;
                f(row, u.pn, cl, acc[ai][0][m][0], acc[ai][0][m][1], acc[ai][1][m][0], acc[ai][1][m][1]);
            }
    }
};
#define ST8(p, a, b) (*(u32x4*)(p) = pack8v((a), (b)))

struct FIn {
    bf16_t *BX, *UU, *QA, *KVA, *SGC, *SGA; const float* bgate;
    __device__ __forceinline__ void operator()(int row, int pn, int cl, f32x4 a0, f32x4 a1, f32x4 b0, f32x4 b1) const {
        if (pn < 4) { if (row < M) { bf16_t* p = BX + (size_t)row * D + pn * 256 + cl; ST8(p, a0, a1); ST8(p + 128, b0, b1); } }
        else if (pn < 12) { if (row < M) { bf16_t* p = UU + (size_t)row * D + (pn - 4) * 128 + cl; ST8(p, a0 * b0, a1 * b1); } }
        else if (pn < 15) {
            const int d0 = (pn - 12) * 256 + cl, d1 = d0 + 128;
            if (d0 < 384) { if (row < M) ST8(QA + (size_t)row * QL + d0, a0, a1); } else if (d0 < 704) ST8(KVA + (size_t)row * 320 + (d0 - 384), a0, a1);
            if (d1 < 384) { if (row < M) ST8(QA + (size_t)row * QL + d1, b0, b1); } else if (d1 < 704) ST8(KVA + (size_t)row * 320 + (d1 - 384), b0, b1);
        } else if (row < M) {
            const bool isa = pn >= 19; const int col = (pn - (isa ? 19 : 15)) * 256 + cl;
            const float* bg = bgate + (isa ? D : 0) + col; bf16_t* p = (isa ? SGA : SGC) + (size_t)row * D + col;
            const f32x4 g0 = *(const f32x4*)bg, g1 = *(const f32x4*)(bg + 4), g2 = *(const f32x4*)(bg + 128), g3 = *(const f32x4*)(bg + 132);
            f32x4 s0, s1, s2, s3;
#pragma unroll
            for (int i = 0; i < 4; ++i) { s0[i] = sigmoidf_(a0[i] + g0[i]); s1[i] = sigmoidf_(a1[i] + g1[i]); s2[i] = sigmoidf_(b0[i] + g2[i]); s3[i] = sigmoidf_(b1[i] + g3[i]); }
            ST8(p, s0, s1); ST8(p + 128, s2, s3);
        }
    }
};
struct FConv {
    const bf16_t* SGC; bf16_t* Z1;
    __device__ __forceinline__ void operator()(int row, int pn, int cl, f32x4 a0, f32x4 a1, f32x4 b0, f32x4 b1) const {
        const size_t o = (size_t)row * D + pn * 256 + cl; float g[8], h[8];
        unpack8(*(const u32x4*)(SGC + o), g); unpack8(*(const u32x4*)(SGC + o + 128), h);
        float r0[8], r1[8];
#pragma unroll
        for (int i = 0; i < 4; ++i) { r0[i] = g[i] * a0[i]; r0[4 + i] = g[4 + i] * a1[i]; r1[i] = h[i] * b0[i]; r1[4 + i] = h[4 + i] * b1[i]; }
        *(u32x4*)(Z1 + o) = pack8(r0); *(u32x4*)(Z1 + o + 128) = pack8(r1);
    }
};
struct FQ {
    bf16_t* Q;
    __device__ __forceinline__ void operator()(int row, int pn, int cl, f32x4 a0, f32x4 a1, f32x4 b0, f32x4 b1) const {
        bf16_t* p = Q + (size_t)row * 1536 + pn * 256 + cl; ST8(p, a0, a1); ST8(p + 128, b0, b1);
    }
};
struct EpiK2 {
    static constexpr bool PERM = true, AFTER_DRAIN = false;
    unsigned char* K; const float *KRB, *KRSS, *knorm; LAS float* T;
    __device__ __forceinline__ void operator()(const pg8::f32x4 (&acc)[2][2][4][2], const pg8::Unit& u, int wr, int wc, int fr, int fq) const {
        int tid = threadIdx.x; asm volatile("" : "+v"(tid));
        asm volatile("" : "+v"(fr), "+v"(fq)); LAS float* S = T + 2048;
#pragma unroll
        for (int ai = 0; ai < 2; ++ai)
#pragma unroll
            for (int m = 0; m < 4; ++m)
#pragma unroll
                for (int bj = 0; bj < 2; ++bj) { const f32x4 a = acc[ai][bj][m][0], b = acc[ai][bj][m][1];
                    float ss = (a[0] * a[0] + a[1] * a[1]) + (a[2] * a[2] + a[3] * a[3]) + (b[0] * b[0] + b[1] * b[1]) + (b[2] * b[2] + b[3] * b[3]);
                    ss += __shfl_xor(ss, 16); ss += __shfl_xor(ss, 32);
                    if (fq == 0) T[((ai * 128 + wr * 64 + m * 16 + fr) * 2 + bj) * 4 + wc] = ss; }
        asm volatile("s_waitcnt lgkmcnt(0)" ::: "memory"); __builtin_amdgcn_s_barrier(); asm volatile("" ::: "memory");
        { const int grow = u.pm * 256 + (tid >> 1); const float ss = (T[tid * 4] + T[tid * 4 + 1]) + (T[tid * 4 + 2] + T[tid * 4 + 3]) + KRSS[grow];
          S[tid] = rsqrtf(ss * (1.f / DK) + EPS); }
        asm volatile("s_waitcnt lgkmcnt(0)" ::: "memory"); __builtin_amdgcn_s_barrier(); asm volatile("" ::: "memory");
        const int cl = wc * 32 + 8 * fq; const f32x4 g0 = *(const f32x4*)(knorm + cl), g1 = *(const f32x4*)(knorm + cl + 4);
#pragma unroll
        for (int ai = 0; ai < 2; ++ai)
#pragma unroll
            for (int m = 0; m < 4; ++m) { const int rl = ai * 128 + wr * 64 + m * 16 + fr, row = u.pm * 256 + rl;
                int b, pos; if (row < M) { b = row >> 13; pos = CTXL + (row & (SEQ - 1)); } else { b = (row - M) >> 8; pos = (row - M) & (CTXL - 1); }
#pragma unroll
                for (int bj = 0; bj < 2; ++bj) { const float r = S[rl * 2 + bj]; const size_t o = (size_t)(b * NH + 2 * u.pn + bj) * SKV + pos;
                    const f32x4 k0 = acc[ai][bj][m][0] * g0 * r, k1 = acc[ai][bj][m][1] * g1 * r; u32x2 w; w.x = pk4_fp8(k0[0], k0[1], k0[2], k0[3]); w.y = pk4_fp8(k1[0], k1[1], k1[2], k1[3]);
                    *(u32x2*)(K + o * DK + cl) = w; } }
        { const int rl = tid >> 1, bj = tid & 1, row = u.pm * 256 + rl; const float r = S[tid];
          int b, pos; if (row < M) { b = row >> 13; pos = CTXL + (row & (SEQ - 1)); } else { b = (row - M) >> 8; pos = (row - M) & (CTXL - 1); }
          unsigned char* p = K + ((size_t)(b * NH + 2 * u.pn + bj) * SKV + pos) * DK + 128; const float* kb = KRB + (size_t)row * 64;
#pragma unroll 1
          for (int i = 0; i < 4; ++i) { const f32x4 x0 = *(const f32x4*)(kb + 16 * i) * r, x1 = *(const f32x4*)(kb + 16 * i + 4) * r, x2 = *(const f32x4*)(kb + 16 * i + 8) * r, x3 = *(const f32x4*)(kb + 16 * i + 12) * r;
              u32x4 w; w.x = pk4_fp8(x0[0], x0[1], x0[2], x0[3]); w.y = pk4_fp8(x1[0], x1[1], x1[2], x1[3]); w.z = pk4_fp8(x2[0], x2[1], x2[2], x2[3]); w.w = pk4_fp8(x3[0], x3[1], x3[2], x3[3]);
              *(u32x4*)(p + 16 * i) = w; } }
    }
};
struct FVt {
    unsigned char* Vt;
    __device__ __forceinline__ void operator()(int row, int pn, int cl, f32x4 a0, f32x4 a1, f32x4 b0, f32x4 b1) const {
        const int h = row >> 7, c = row & 127;
#pragma unroll
        for (int bj = 0; bj < 2; ++bj) { const int t0 = pn * 256 + bj * 128 + cl;
            int b, pos; if (t0 < M) { b = t0 >> 13; pos = CTXL + (t0 & (SEQ - 1)); } else { b = (t0 - M) >> 8; pos = (t0 - M) & (CTXL - 1); }
            const f32x4 x = bj ? b0 : a0, y = bj ? b1 : a1; u32x2 w; w.x = pk4_fp8(x[0], x[1], x[2], x[3]); w.y = pk4_fp8(y[0], y[1], y[2], y[3]);
            *(u32x2*)(Vt + ((((size_t)(b * NH + h) * (SKV / 64) + (pos >> 6)) * 128 + c) << 6) + (pos & 63)) = w; }
    }
};
struct FAo {
    const bf16_t* SGA; bf16_t* Z;
    __device__ __forceinline__ void operator()(int row, int pn, int cl, f32x4 a0, f32x4 a1, f32x4 b0, f32x4 b1) const {
        const size_t o = (size_t)row * D + pn * 256 + cl; float g[8], h[8], z0[8], z1[8];
        unpack8(*(const u32x4*)(SGA + o), g); unpack8(*(const u32x4*)(SGA + o + 128), h);
        unpack8(*(const u32x4*)(Z + o), z0); unpack8(*(const u32x4*)(Z + o + 128), z1);
#pragma unroll
        for (int i = 0; i < 4; ++i) { z0[i] += g[i] * a0[i]; z0[4 + i] += g[4 + i] * a1[i]; z1[i] += h[i] * b0[i]; z1[4 + i] += h[4 + i] * b1[i]; }
        *(u32x4*)(Z + o) = pack8(z0); *(u32x4*)(Z + o + 128) = pack8(z1);
    }
};
struct FRes {
    const float* base; float* out; const float* gate;
    __device__ __forceinline__ void operator()(int row, int pn, int cl, f32x4 a0, f32x4 a1, f32x4 b0, f32x4 b1) const {
        const int col = pn * 256 + cl; const size_t o = (size_t)row * D + col; const float* g = gate + (row >> 13) * 6144 + col;
        const f32x4 x0 = *(const f32x4*)(base + o), x1 = *(const f32x4*)(base + o + 4), x2 = *(const f32x4*)(base + o + 128), x3 = *(const f32x4*)(base + o + 132);
        const f32x4 g0 = *(const f32x4*)g, g1 = *(const f32x4*)(g + 4), g2 = *(const f32x4*)(g + 128), g3 = *(const f32x4*)(g + 132);
        *(f32x4*)(out + o) = x0 + g0 * a0; *(f32x4*)(out + o + 4) = x1 + g1 * a1; *(f32x4*)(out + o + 128) = x2 + g2 * b0; *(f32x4*)(out + o + 132) = x3 + g3 * b1;
    }
};
struct FRes2 {
    const float* base; float* out; const float* mod; const float* nffn; bf16_t* HX2; float* ROWSS;
    __device__ __forceinline__ void operator()(int row, int pn, int cl, f32x4 a0, f32x4 a1, f32x4 b0, f32x4 b1) const {
        const int col = pn * 256 + cl; const size_t o = (size_t)row * D + col; const float* md = mod + (row >> 13) * 6144 + col;
        const f32x4 x0 = *(const f32x4*)(base + o), x1 = *(const f32x4*)(base + o + 4), x2 = *(const f32x4*)(base + o + 128), x3 = *(const f32x4*)(base + o + 132);
        const float* g = md + 2 * D; const f32x4 g0 = *(const f32x4*)g, g1 = *(const f32x4*)(g + 4), g2 = *(const f32x4*)(g + 128), g3 = *(const f32x4*)(g + 132);
        const f32x4 y0 = x0 + g0 * a0, y1 = x1 + g1 * a1, y2 = x2 + g2 * b0, y3 = x3 + g3 * b1;
        *(f32x4*)(out + o) = y0; *(f32x4*)(out + o + 4) = y1; *(f32x4*)(out + o + 128) = y2; *(f32x4*)(out + o + 132) = y3;
        const f32x4 q = y0 * y0 + y1 * y1 + y2 * y2 + y3 * y3; float ss = (q[0] + q[1]) + (q[2] + q[3]);
        ss += __shfl_xor(ss, 16); ss += __shfl_xor(ss, 32);
        if ((threadIdx.x & 48) == 0) unsafeAtomicAdd(ROWSS + row, ss);
        const float* sc = md + 4 * D; const float* nf = nffn + col;
        const f32x4 s0 = *(const f32x4*)sc + 1.f, s1 = *(const f32x4*)(sc + 4) + 1.f, s2 = *(const f32x4*)(sc + 128) + 1.f, s3 = *(const f32x4*)(sc + 132) + 1.f;
        const f32x4 n0 = *(const f32x4*)nf, n1 = *(const f32x4*)(nf + 4), n2 = *(const f32x4*)(nf + 128), n3 = *(const f32x4*)(nf + 132);
        ST8(HX2 + o, y0 * n0 * s0, y1 * n1 * s1); ST8(HX2 + o + 128, y2 * n2 * s2, y3 * n3 * s3);
    }
};
struct FFfn1 {
    bf16_t* H; const float* ROWSS; const float* SHW;
    __device__ __forceinline__ void operator()(int row, int pn, int cl, f32x4 a0, f32x4 a1, f32x4 b0, f32x4 b1) const {
        const float r = rsqrtf(ROWSS[row] * (1.f / D) + EPS); const float* sw = SHW + (row >> 13) * (2 * DFF) + pn * 256 + cl;
        const f32x4 c0 = *(const f32x4*)sw, c1 = *(const f32x4*)(sw + 4), c2 = *(const f32x4*)(sw + 128), c3 = *(const f32x4*)(sw + 132);
        a0 = a0 * r + c0; a1 = a1 * r + c1; b0 = b0 * r + c2; b1 = b1 * r + c3;
        f32x4 h0, h1;
#pragma unroll
        for (int i = 0; i < 4; ++i) { h0[i] = siluf_(a0[i]) * b0[i]; h1[i] = siluf_(a1[i]) * b1[i]; }
        ST8(H + (size_t)row * DFF + pn * 128 + cl, h0, h1);
    }
};

namespace att {
using bf16x8 = __attribute__((ext_vector_type(8))) short;
using s16x4 = __attribute__((ext_vector_type(4))) short;
using f32x16 = __attribute__((ext_vector_type(16))) float;
using v8i = __attribute__((ext_vector_type(8))) int;
constexpr int NW = 8, QBLK = 32, KVBLK = 64, LDQ = 1536, LDO = 1024;
constexpr float SCALE = 0.07216878364870322f;
constexpr float THR = 3.3f;
constexpr float PSHIFT = 4.f;
constexpr float QC = SCALE * 1.4426950408889634f;
constexpr float THRL = THR * 1.4426950408889634f;
constexpr int KROW = 208;
constexpr int VROW = 80;
constexpr int SHM_V = DV * VROW, SHM_K = KVBLK * KROW;
constexpr int SLOT = SHM_K + SHM_V, NSLOT = 5;
constexpr int LDS_WS = NSLOT * SLOT, LDS_ATT = LDS_WS + NW * 64 * 4;
#define SBAR() __builtin_amdgcn_sched_barrier(0)
__device__ __forceinline__ int crow(int r, int hi) { return (r & 3) + 8 * (r >> 2) + 4 * hi; }
__device__ __forceinline__ unsigned cvtpk(float lo, float hi) { unsigned r; asm volatile("v_cvt_pk_bf16_f32 %0, %1, %2" : "=v"(r) : "v"(lo), "v"(hi)); return r; }
__device__ __forceinline__ void smx(f32x16& p0, f32x16& p1, f32x16& q0, f32x16& q1, float& nm, f32x16& negm, float& alpha, float& l_reg, bool first, v8i& pf) {
    float pmax = p0[0];
#pragma unroll
    for (int r = 1; r < 16; ++r) pmax = fmaxf(pmax, p0[r]);
#pragma unroll
    for (int r = 0; r < 16; ++r) pmax = fmaxf(pmax, p1[r]);
    { auto rr = __builtin_amdgcn_permlane32_swap(__float_as_uint(pmax), __float_as_uint(pmax), false, false);
      pmax = fmaxf(__uint_as_float(rr[0]), __uint_as_float(rr[1])); }
    alpha = 1.f;
    if (__builtin_expect(first || __any(pmax > PSHIFT + THRL), 0)) {
        asm volatile("" ::: "memory");
        const float delta = first ? pmax - PSHIFT : fmaxf(pmax - PSHIFT, 0.f);
        nm -= delta; alpha = __builtin_amdgcn_exp2f(-delta);
#pragma unroll
        for (int r = 0; r < 16; ++r) { p0[r] -= delta; p1[r] -= delta; q0[r] -= delta; q1[r] -= delta; negm[r] = nm; }
        asm volatile("" : "+v"(negm));
    }
#pragma unroll
    for (int r = 0; r < 16; ++r) p0[r] = __builtin_amdgcn_exp2f(p0[r]);
#pragma unroll
    for (int r = 0; r < 16; ++r) p1[r] = __builtin_amdgcn_exp2f(p1[r]);
    float ps = 0;
#pragma unroll
    for (int r = 0; r < 16; ++r) ps += p0[r];
#pragma unroll
    for (int r = 0; r < 16; ++r) ps += p1[r];
    { auto rr = __builtin_amdgcn_permlane32_swap(__float_as_uint(ps), __float_as_uint(ps), false, false);
      ps = __uint_as_float(rr[0]) + __uint_as_float(rr[1]); }
    l_reg = l_reg * alpha + ps;
#pragma unroll
    for (int i = 0; i < 4; ++i) { pf[i] = (int)pk4_fp8(p0[4 * i], p0[4 * i + 1], p0[4 * i + 2], p0[4 * i + 3]); pf[4 + i] = (int)pk4_fp8(p1[4 * i], p1[4 * i + 1], p1[4 * i + 2], p1[4 * i + 3]); }
}
__device__ __forceinline__ void qkt(f32x16& p0, f32x16& p1, const char* Ks, const v8i* qf, const f32x16& negm, int r32, int hi) {
    p0 = negm; p1 = negm;
    const char* kp = Ks + r32 * KROW + 32 * hi;
#define KLD(s, X0, X1, Y0, Y1) const u32x4 X0 = *reinterpret_cast<const u32x4*>(kp + 64 * (s)), X1 = *reinterpret_cast<const u32x4*>(kp + 64 * (s) + 16), \
    Y0 = *reinterpret_cast<const u32x4*>(kp + 32 * KROW + 64 * (s)), Y1 = *reinterpret_cast<const u32x4*>(kp + 32 * KROW + 64 * (s) + 16)
#define KMM(s, X0, X1, Y0, Y1) do { const v8i A0 = {(int)X0.x, (int)X0.y, (int)X0.z, (int)X0.w, (int)X1.x, (int)X1.y, (int)X1.z, (int)X1.w}; \
    const v8i A1 = {(int)Y0.x, (int)Y0.y, (int)Y0.z, (int)Y0.w, (int)Y1.x, (int)Y1.y, (int)Y1.z, (int)Y1.w}; \
    p0 = __builtin_amdgcn_mfma_scale_f32_32x32x64_f8f6f4(A0, qf[s], p0, 0, 0, 0, 0, 0, 0); \
    p1 = __builtin_amdgcn_mfma_scale_f32_32x32x64_f8f6f4(A1, qf[s], p1, 0, 0, 0, 0, 0, 0); } while (0)
    KLD(0, a0, a1, a2, a3);
    KLD(1, b0, b1, b2, b3); KMM(0, a0, a1, a2, a3); __builtin_amdgcn_sched_barrier(0x40E);
    KLD(2, c0, c1, c2, c3); KMM(1, b0, b1, b2, b3);
    KMM(2, c0, c1, c2, c3);
#undef KLD
#undef KMM
}
__device__ __forceinline__ void pv_d0(f32x16* o, const char* Vs, const v8i pf, int r32, int hi) {
    const char* vp = Vs + r32 * VROW + 16 * hi;
#pragma unroll
    for (int d0 = 0; d0 < 4; ++d0) {
        const u32x4 x0 = *reinterpret_cast<const u32x4*>(vp + d0 * 32 * VROW), x1 = *reinterpret_cast<const u32x4*>(vp + d0 * 32 * VROW + 32);
        const v8i B = {(int)x0.x, (int)x0.y, (int)x0.z, (int)x0.w, (int)x1.x, (int)x1.y, (int)x1.z, (int)x1.w};
        o[d0] = __builtin_amdgcn_mfma_scale_f32_32x32x64_f8f6f4(pf, B, o[d0], 0, 0, 0, 0, 0, 0);
        if (d0 == 1) __builtin_amdgcn_sched_barrier(0x40E); }
}
__device__ __forceinline__ void attn_unit(const bf16_t* __restrict__ Qb, const unsigned char* __restrict__ Kh, const unsigned char* __restrict__ Vh, bf16_t* __restrict__ Ob, char* lds, LAS unsigned char* ldsl,
                                          const float* __restrict__ qnorm, const float* __restrict__ rope, int tl0) {
    int tid = threadIdx.x; asm volatile("" : "+v"(tid));
    const int wid = tid >> 6, lane = tid & 63, r32 = lane & 31, hi = lane >> 5;
    char* ring = lds;
    unsigned doff[3];
#pragma unroll
    for (int k = 0; k < 3; ++k) { const int ii = wid + 8 * k, p = ii * 1024 + lane * 16;
        const int row = p / KROW, col = p - row * KROW, rr = row & 31, key = (row & 32) | (((rr >> 2) & 1) << 4) | (rr & 3) | ((rr >> 3) << 2); const int dk = col < DK ? key * DK + col : 0;
        const int pv = p - SHM_K, c = pv / VROW, cv = pv - c * VROW; const int dv = cv < 64 ? c * 64 + cv : 0;
        doff[k] = (unsigned)(ii < 13 ? dk : dv); }
    unsigned dpk = doff[0] | (doff[1] << 16), dp2 = doff[2];
    asm volatile("" : "+v"(dpk), "+v"(dp2));
    float* ws = (float*)(lds + LDS_WS) + wid * 64; float* al_l = ws;
    v8i qf[3];
    {
        const bf16_t* Qr = Qb + (size_t)(wid * QBLK + r32) * LDQ + 32 * hi; float ss = 0.f;
#pragma unroll
        for (int c = 0; c < 12; ++c) { float v[8]; unpack8(*reinterpret_cast<const u32x4*>(Qr + 64 * (c >> 2) + 8 * (c & 3)), v);
#pragma unroll
            for (int i = 0; i < 8; ++i) ss += v[i] * v[i];
            if ((c & 3) == 3) asm volatile("" ::: "memory"); }
        { auto rr = __builtin_amdgcn_permlane32_swap(__float_as_uint(ss), __float_as_uint(ss), false, false); ss = __uint_as_float(rr[0]) + __uint_as_float(rr[1]); }
        const float rq = rsqrtf(ss * (1.f / DK) + EPS);
        asm volatile("" ::: "memory");
#pragma unroll
        for (int s = 0; s < 2; ++s)
#pragma unroll
            for (int c = 0; c < 4; ++c) { float v[8]; unpack8(*reinterpret_cast<const u32x4*>(Qr + 64 * s + 8 * c), v); const float* g = qnorm + 64 * s + 32 * hi + 8 * c;
#pragma unroll
                for (int i = 0; i < 8; ++i) v[i] = v[i] * (rq * QC) * g[i];
                qf[s][2 * c] = (int)pk4_fp8(v[0], v[1], v[2], v[3]); qf[s][2 * c + 1] = (int)pk4_fp8(v[4], v[5], v[6], v[7]);
                asm volatile("" ::: "memory"); }
        const float* rt = rope + (size_t)(tl0 + wid * QBLK + r32) * 64 + hi * 16; const float* g = qnorm + 128 + 32 * hi;
#pragma unroll
        for (int c = 0; c < 2; ++c) { float x1[8], x2[8], oa[8], ob[8]; unpack8(*reinterpret_cast<const u32x4*>(Qr + 128 + 8 * c), x1); unpack8(*reinterpret_cast<const u32x4*>(Qr + 144 + 8 * c), x2);
#pragma unroll
            for (int i = 0; i < 8; ++i) { const float a = x1[i] * (rq * QC) * g[8 * c + i], b = x2[i] * (rq * QC) * g[16 + 8 * c + i], cs = rt[8 * c + i], sn = rt[32 + 8 * c + i]; oa[i] = a * cs - b * sn; ob[i] = a * sn + b * cs; }
            qf[2][2 * c] = (int)pk4_fp8(oa[0], oa[1], oa[2], oa[3]); qf[2][2 * c + 1] = (int)pk4_fp8(oa[4], oa[5], oa[6], oa[7]);
            qf[2][4 + 2 * c] = (int)pk4_fp8(ob[0], ob[1], ob[2], ob[3]); qf[2][4 + 2 * c + 1] = (int)pk4_fp8(ob[4], ob[5], ob[6], ob[7]);
            asm volatile("" ::: "memory"); }
    }
    asm volatile("" : "+v"(qf[0]), "+v"(qf[1]), "+v"(qf[2]));
    float nm = 0.f, l_reg = 0.f; f32x16 o[4] = {}, negm = {};
    const int wuni = __builtin_amdgcn_readfirstlane(wid);
#define KOF(s) ((s) * SLOT)
#define VOF(s) ((s) * SLOT + SHM_K)
#define NEXT(s) ((s) == NSLOT - 1 ? 0 : (s) + 1)
#define DMA(t, s) do { const unsigned char* kt_ = Kh + (size_t)(t) * (KVBLK * DK); const unsigned char* vt_ = Vh + (size_t)(t) * (KVBLK * DV); \
    _Pragma("unroll") for (int k_ = 0; k_ < 3; ++k_) { const int ii_ = wuni + 8 * k_; if (ii_ < 23) \
        __builtin_amdgcn_global_load_lds((const unsigned*)((ii_ < 13 ? kt_ : vt_) + (k_ == 0 ? (dpk & 0xffffu) : k_ == 1 ? (dpk >> 16) : dp2)), (LAS unsigned*)(ldsl + (s) * SLOT + ii_ * 1024), 16, 0, 0); } } while (0)
#define DWAIT() asm volatile("s_waitcnt vmcnt(0)" ::: "memory")
#define RESC(a) do { if (__any((a) < 1.f)) { if (hi == 0) al_l[r32] = (a); asm volatile("s_waitcnt lgkmcnt(0)" ::: "memory"); \
    _Pragma("unroll") for (int r = 0; r < 16; ++r) { const float f_ = al_l[crow(r, hi)]; _Pragma("unroll") for (int d = 0; d < 4; ++d) o[d][r] *= f_; } } } while (0)
    f32x16 pA0, pA1, pB0, pB1; float alA; v8i pf; constexpr int NT = SKV / KVBLK;
    DMA(0, 0); DMA(1, 1); DMA(2, 2); DWAIT(); __syncthreads();
    if (wuni >= 4) __builtin_amdgcn_s_setprio(1);
    qkt(pA0, pA1, ring + KOF(0), qf, negm, r32, hi);
    int s0 = 0;
    for (int j = 0; j < NT; j += 2) {
        const int s1 = NEXT(s0), s2 = NEXT(s1), s3 = NEXT(s2), s4 = NEXT(s3);
        if (j + 3 < NT) DMA(j + 3, s3); if (j + 4 < NT) DMA(j + 4, s4);
        qkt(pB0, pB1, ring + KOF(s1), qf, negm, r32, hi);
        smx(pA0, pA1, pB0, pB1, nm, negm, alA, l_reg, j == 0, pf); RESC(alA);
        pv_d0(o, ring + VOF(s0), pf, r32, hi);
        if (j + 2 < NT) qkt(pA0, pA1, ring + KOF(s2), qf, negm, r32, hi);
        smx(pB0, pB1, pA0, pA1, nm, negm, alA, l_reg, false, pf); RESC(alA);
        pv_d0(o, ring + VOF(s1), pf, r32, hi);
        DWAIT(); __syncthreads();
        s0 = s2;
    }
    if (hi == 0) al_l[r32] = l_reg; asm volatile("s_waitcnt lgkmcnt(0)" ::: "memory");
    float rli[16];
#pragma unroll
    for (int r = 0; r < 16; ++r) rli[r] = __builtin_amdgcn_rcpf(al_l[crow(r, hi)]);
    bf16_t* Ow = Ob + (size_t)(wid * QBLK) * LDO;
#pragma unroll
    for (int r = 0; r < 16; ++r) { const int orow = crow(r, hi);
#pragma unroll
        for (int d0 = 0; d0 < 4; ++d0) Ow[(size_t)orow * LDO + d0 * 32 + r32] = f2bf1(o[d0][r] * rli[r]); }
    __builtin_amdgcn_s_setprio(0);
    __syncthreads();
#undef DMA
#undef DWAIT
#undef KOF
#undef VOF
#undef NEXT
#undef RESC
}
#undef SBAR
}
static_assert(att::LDS_ATT <= 131072, "attention LDS");

enum { MAP_ID = 0, MAP_WIN = 1, MAP_FF1 = 2, MAP_KV = 3 };
__device__ __forceinline__ int map_row(int mode, int n0) {
    if (mode == MAP_WIN) {
        if (n0 < 1024) return n0;
        if (n0 < 2048) { const int j = (n0 - 1024) >> 7, r = (n0 - 1024) & 127; return 1024 + 256 * j + r; }
        if (n0 < 3072) { const int j = (n0 - 2048) >> 7, r = (n0 - 2048) & 127; return 1024 + 256 * j + 128 + r; }
        if (n0 < 3776) return n0;
        return n0 + 64;
    } else if (mode == MAP_KV) {
        const int h = n0 >> 8, j = n0 & 255; return j < 128 ? h * 128 + j : 1024 + h * 128 + (j - 128);
    } else if (mode == MAP_FF1) {
        if (n0 < DFF) { const int j = n0 >> 7, r = n0 & 127; return 256 * j + r; }
        const int n1 = n0 - DFF, j = n1 >> 7, r = n1 & 127; return 256 * j + 128 + r;
    }
    return n0;
}
__device__ __forceinline__ void transpose_item(const float* W, int K, int N, bf16_t* WT, int mode, LAS float* scr, int item, int lane) {
    const int nblk = N / 32, kb = item / nblk, nb = item % nblk, k0 = 64 * kb, n0 = 32 * nb;
    float t_[32];
#pragma unroll
    for (int i = 0; i < 32; ++i) t_[i] = __builtin_nontemporal_load(&W[(size_t)(k0 + 2 * i + (lane >> 5)) * N + n0 + (lane & 31)]);
#pragma unroll
    for (int i = 0; i < 32; ++i) scr[(2 * i + (lane >> 5)) * 33 + (lane & 31)] = t_[i];
    asm volatile("s_waitcnt lgkmcnt(0)" ::: "memory");
    const int c = lane & 7, dr0 = map_row(mode, n0);
#pragma unroll
    for (int j = 0; j < 4; ++j) { const int n = (lane >> 3) + 8 * j; const LAS float* s = scr + (8 * c) * 33 + n;
        u32x4 o; o.x = pk2(s[0 * 33], s[1 * 33]); o.y = pk2(s[2 * 33], s[3 * 33]); o.z = pk2(s[4 * 33], s[5 * 33]); o.w = pk2(s[6 * 33], s[7 * 33]);
        *(u32x4*)(WT + (size_t)(dr0 + n) * K + k0 + 8 * c) = o; }
    asm volatile("s_waitcnt lgkmcnt(0)" ::: "memory");
}
__device__ __forceinline__ void norm_mod_row(const float* __restrict__ xrow, const float* __restrict__ gain, const float* __restrict__ shift, const float* __restrict__ scale, bf16_t* __restrict__ orow, int lane) {
    const f32x4* xr = (const f32x4*)xrow + lane; f32x4 v[4]; float s = 0.f;
#pragma unroll
    for (int j = 0; j < 4; ++j) { v[j] = __builtin_nontemporal_load(xr + 64 * j); s += (v[j].x * v[j].x + v[j].y * v[j].y) + (v[j].z * v[j].z + v[j].w * v[j].w); }
    const float r = rsqrtf(wave_sum(s) * (1.f / D) + EPS);
    u32x2* o8 = (u32x2*)orow + lane;
#pragma unroll
    for (int j = 0; j < 4; ++j) { const int c = 4 * lane + 256 * j;
        const f32x4 g = *(const f32x4*)(gain + c), sc = *(const f32x4*)(scale + c), sh = *(const f32x4*)(shift + c);
        const f32x4 y = (v[j] * r) * g * (sc + 1.f) + sh; u32x2 w; w.x = pk2(y.x, y.y); w.y = pk2(y.z, y.w); o8[64 * j] = w; }
}
__device__ __forceinline__ void rope_cs(int tl, int lane, float& c, float& s) {
    const float fr = exp2f(-(float)(lane & 15) * (13.287712379549449f / 16.f));
    const float pos = (float)((lane >> 5) ? (tl & 63) : (tl >> 6));
    sincosf(pos * fr, &s, &c);
}
__device__ __forceinline__ float rope_apply(float w, float c, float s, int lane) {
    const float p = __shfl_xor(w, 16);
    return (lane & 16) ? (p * s + w * c) : (w * c - p * s);
}

#define XB_TMO      128
#define XB_XCNT(j)  (256  + 64 * (j))
#define XB_XSUB(j)  (1280 + 64 * (j))
#define XB_XGEN(j)  (2304 + 64 * (j))
#define XB_TOP      3328
#define XB_TOPGEN   3392
#define XCD_BAR_WORDS 3456
#define XB_SPIN_CAP (1u << 18)

__device__ __forceinline__ unsigned xb_ld(unsigned* p)              { return __hip_atomic_load(p, __ATOMIC_RELAXED, __HIP_MEMORY_SCOPE_AGENT); }
__device__ __forceinline__ unsigned xb_add(unsigned* p, unsigned v) { return __hip_atomic_fetch_add(p, v, __ATOMIC_RELAXED, __HIP_MEMORY_SCOPE_AGENT); }
__device__ __forceinline__ unsigned xb_xcc_id() { return (unsigned)__builtin_amdgcn_s_getreg((3 << 11) | 20) & 0xFu; }
#define XB_SPIN(cond, bar) do { unsigned _sp = 0; while (cond) { __builtin_amdgcn_s_sleep(1); \
    if ((++_sp & 255u) == 0u) { if (xb_ld(&(bar)[XB_TMO])) break; if (_sp > XB_SPIN_CAP) { atomicAdd(&(bar)[XB_TMO], 1u); break; } } } } while (0)

struct XcdBarrier {
    unsigned* bar; unsigned x;
    volatile LAS unsigned* st;
};

__device__ __forceinline__ XcdBarrier xcd_barrier_post(unsigned* bar, volatile LAS unsigned* st) {
    XcdBarrier b; b.bar = bar; b.x = xb_xcc_id(); b.st = st;
    if (threadIdx.x == 0) (void)xb_add(&bar[XB_XCNT(b.x)], 1u);
    return b;
}
__device__ __forceinline__ void xcd_barrier_complete(unsigned* bar, unsigned x, unsigned& nloc, unsigned& nx) {
    const unsigned G = gridDim.x * gridDim.y * gridDim.z;
    unsigned sum, cnt, mine, sp = 0u;
    for (;;) {
        sum = 0u; cnt = 0u; mine = 0u;
#pragma unroll
        for (unsigned j = 0; j < 16; ++j) { const unsigned c = xb_ld(&bar[XB_XCNT(j)]); sum += c; cnt += (c > 0u) ? 1u : 0u; mine = (j == x) ? c : mine; }
        if (sum == G) break;
        __builtin_amdgcn_s_sleep(1);
        if ((++sp & 255u) == 0u) { if (xb_ld(&bar[XB_TMO])) break; if (sp > XB_SPIN_CAP) { atomicAdd(&bar[XB_TMO], 1u); break; } }
    }
    nloc = mine > 0u ? mine : 1u; nx = cnt > 0u ? cnt : 1u;
}

__device__ __forceinline__ void xcd_barrier(const XcdBarrier& b) {
    asm volatile("s_waitcnt vmcnt(0)" ::: "memory");
    __syncthreads();
    if (threadIdx.x == 0) {
        unsigned* bar = b.bar;
        __builtin_amdgcn_s_waitcnt(0);
        unsigned nloc = b.st[0], nx = b.st[1];
        if (nloc == 0u) { xcd_barrier_complete(bar, b.x, nloc, nx); b.st[0] = nloc; b.st[1] = nx; }
        const unsigned old = xb_add(&bar[XB_XSUB(b.x)], 1u);
        const unsigned gen = old / nloc;
        if (old + 1u == (gen + 1u) * nloc) {
            __builtin_amdgcn_fence(__ATOMIC_RELEASE, "agent");
            asm volatile("s_waitcnt vmcnt(0)" ::: "memory");
            const unsigned og = xb_add(&bar[XB_TOP], 1u);
            const unsigned tg = og / nx;
            if (og + 1u == (tg + 1u) * nx) xb_add(&bar[XB_TOPGEN], 1u);
            else XB_SPIN(xb_ld(&bar[XB_TOPGEN]) == tg, bar);
            __builtin_amdgcn_fence(__ATOMIC_ACQUIRE, "agent");
            asm volatile("s_waitcnt vmcnt(0)" ::: "memory");
        } else {
            XB_SPIN(xb_ld(&bar[XB_TOPGEN]) == gen, bar);
            __builtin_amdgcn_fence(__ATOMIC_ACQUIRE, "agent");
            asm volatile("s_waitcnt vmcnt(0)" ::: "memory");
        }
    }
    __syncthreads();
}

__device__ __forceinline__ void xcd_barrier_arrive(const XcdBarrier& b) {
    asm volatile("s_waitcnt vmcnt(0)" ::: "memory");
    __syncthreads();
    if (threadIdx.x == 0) {
        unsigned* bar = b.bar;
        __builtin_amdgcn_s_waitcnt(0);
        unsigned nloc = b.st[0], nx = b.st[1];
        if (nloc == 0u) { xcd_barrier_complete(bar, b.x, nloc, nx); b.st[0] = nloc; b.st[1] = nx; }
        const unsigned old = xb_add(&bar[XB_XSUB(b.x)], 1u);
        const unsigned gen = old / nloc;
        b.st[2] = gen;
        if (old + 1u == (gen + 1u) * nloc) {
            __builtin_amdgcn_fence(__ATOMIC_RELEASE, "agent");
            asm volatile("s_waitcnt vmcnt(0)" ::: "memory");
            const unsigned og = xb_add(&bar[XB_TOP], 1u);
            const unsigned tg = og / nx;
            if (og + 1u == (tg + 1u) * nx) xb_add(&bar[XB_TOPGEN], 1u);
        }
    }
}
__device__ __forceinline__ void xcd_barrier_wait(const XcdBarrier& b) {
    if (threadIdx.x == 0) {
        unsigned* bar = b.bar; const unsigned gen = b.st[2];
        XB_SPIN(xb_ld(&bar[XB_TOPGEN]) == gen, bar);
        __builtin_amdgcn_fence(__ATOMIC_ACQUIRE, "agent");
        asm volatile("s_waitcnt vmcnt(0)" ::: "memory");
    }
    __syncthreads();
}

struct Args { const float* in[23]; float* out; unsigned char* ws; int lo, hi; };
constexpr int NPHASE = 12;

__global__ void __launch_bounds__(512, 2) mega_fwd(Args args) {
    extern __shared__ __attribute__((aligned(16))) unsigned char lds[];
    cg::grid_group grid = cg::this_grid();
    const int tid = threadIdx.x, lane = tid & 63, wave = __builtin_amdgcn_readfirstlane(tid >> 6);
    const int G = gridDim.x, bx = blockIdx.x, vcu = (G % 8 == 0) ? (bx % 8) * (G / 8) + bx / 8 : bx;
    const int gw = vcu * 8 + wave, NGW = G * 8;
    unsigned char* ws = args.ws;
    const float *x = args.in[0], *cnd = args.in[1], *ctx = args.in[2], *cctx = args.in[3], *w_mod = args.in[4], *b_mod = args.in[5], *norm_mix = args.in[6], *norm_ffn = args.in[7],
                *w_in = args.in[8], *b_gate = args.in[9], *conv_w = args.in[10], *conv_b = args.in[11], *w_conv_out = args.in[12], *q_a_norm = args.in[13], *w_q_b = args.in[14],
                *kv_a_norm = args.in[15], *w_kv_b = args.in[16], *q_norm = args.in[17], *k_norm = args.in[18], *w_attn_o = args.in[19], *w_out = args.in[20], *w_ffn_in = args.in[21], *w_ffn_out = args.in[22];
    float* MOD = (float*)(ws + WS_MOD);
    bf16_t *WIN = (bf16_t*)(ws + WS_WIN), *WC = (bf16_t*)(ws + WS_WC), *WQ = (bf16_t*)(ws + WS_WQ), *WKV = (bf16_t*)(ws + WS_WKV), *WA = (bf16_t*)(ws + WS_WA), *WO = (bf16_t*)(ws + WS_WO),
           *WF1 = (bf16_t*)(ws + WS_WF1), *WF2 = (bf16_t*)(ws + WS_WF2);
    bf16_t *XN = (bf16_t*)(ws + WS_XN), *BX = (bf16_t*)(ws + WS_BX), *QAN = (bf16_t*)(ws + WS_QAN), *KVAN = (bf16_t*)(ws + WS_KVAN), *UU = (bf16_t*)(ws + WS_UU), *QA = (bf16_t*)(ws + WS_QA),
           *KVA = (bf16_t*)(ws + WS_KVA), *Qb = (bf16_t*)(ws + WS_Q), *Hb = (bf16_t*)(ws + WS_H);
    unsigned char* Kb = ws + WS_K;
    unsigned char* Vtb = ws + WS_V;
    float *KRB = (float*)(ws + WS_KRB), *KRSS = (float*)(ws + WS_KRSS), *ROWSS = (float*)(ws + WS_ROWSS), *SHW = (float*)(ws + WS_SHW), *ROPE = (float*)(ws + WS_ROPE);
    bf16_t *SGC = (bf16_t*)args.out, *SGA = (bf16_t*)args.out + (size_t)M * D;
    bf16_t *U = XN, *Ob = XN, *HX2 = XN, *Z = BX;
    const int lo = args.lo, hi = args.hi;
#ifndef PH_MASK
#define PH_MASK 0x7FFF
#endif
#define IN(k) (((PH_MASK >> (k)) & 1) && lo <= (k) && (k) < hi)
#ifndef DUP_MASK
#define DUP_MASK 0
#endif
#define REP(k) for (int rep_ = 0; rep_ < (((DUP_MASK >> (k)) & 1) ? 2 : 1); ++rep_)
#ifndef MK_CG_SEAM0
#define MK_CG_SEAM0 0
#endif
#define SEAM2(k, k2) do { if (IN(k) && IN(k2)) xcd_barrier(xbar); } while (0)
#define SEAM(k) do { if (IN(k) && IN((k) + 1)) { if ((k) == 0 && MK_CG_SEAM0) grid.sync(); else xcd_barrier(xbar); } } while (0)
    LAS unsigned char* ldsl = (LAS unsigned char*)lds;
    constexpr int CI_C = 16 * 32, CI_Q = (QL / 64) * (1536 / 32), CI_KV = (KVL / 64) * (2048 / 32), CI_F1 = 16 * (2 * DFF / 32), CI_F2 = (DFF / 64) * 32;
    constexpr int CO_Q = CI_C, CO_KV = CO_Q + CI_Q, CO_A = CO_KV + CI_KV, CO_O = CO_A + CI_C, CO_F1 = CO_O + CI_C, CO_F2 = CO_F1 + CI_F1, CO_END = CO_F2 + CI_F2;
#define CONV(lo_, hi_) do { LAS float* scr_ = (LAS float*)(ldsl + wave * 16384); for (int it_ = (lo_) + gw; it_ < (hi_); it_ += NGW) { \
        if (it_ < CO_Q) transpose_item(w_conv_out, D, D, WC, MAP_ID, scr_, it_, lane); \
        else if (it_ < CO_KV) transpose_item(w_q_b, QL, 1536, WQ, MAP_ID, scr_, it_ - CO_Q, lane); \
        else if (it_ < CO_A) transpose_item(w_kv_b, KVL, 2048, WKV, MAP_KV, scr_, it_ - CO_KV, lane); \
        else if (it_ < CO_O) transpose_item(w_attn_o, D, D, WA, MAP_ID, scr_, it_ - CO_A, lane); \
        else if (it_ < CO_F1) transpose_item(w_out, D, D, WO, MAP_ID, scr_, it_ - CO_O, lane); \
        else if (it_ < CO_F2) transpose_item(w_ffn_in, D, 2 * DFF, WF1, MAP_FF1, scr_, it_ - CO_F1, lane); \
        else transpose_item(w_ffn_out, DFF, D, WF2, MAP_ID, scr_, it_ - CO_F2, lane); } } while (0)
#define SEAMW(work_) do { xcd_barrier_arrive(xbar); work_; xcd_barrier_wait(xbar); } while (0)
    volatile LAS unsigned* xst = (volatile LAS unsigned*)(ldsl + LDS_BYTES - 64);
    if (tid < 2) xst[tid] = 0u;
    __syncthreads();
    XcdBarrier xbar = xcd_barrier_post((unsigned*)(ws + WS_BAR), xst);
    if (args.ws == nullptr) grid.sync();

#ifdef EXTRA_SYNCS
    for (int i_ = 0; i_ < EXTRA_SYNCS; ++i_) grid.sync();
#endif
    if (IN(0)) {
        for (int cb = bx; cb < 256; cb += G) {
            LAS float* red = (LAS float*)ldsl;
            if (tid < 510) { const int q = tid % 6, ks = tid / 6; const float* wp = w_mod + cb * 24 + q * 4;
                f32x4 a0 = {0.f, 0.f, 0.f, 0.f}, a1 = a0, a2 = a0;
#pragma unroll 13
                for (int k = ks; k < D; k += 85) { const f32x4 w = __builtin_nontemporal_load((const f32x4*)(wp + (size_t)k * 6144));
                    const float s0 = siluf_(cnd[k]), s1 = siluf_(cnd[D + k]), s2 = siluf_(cctx[k]); a0 += w * s0; a1 += w * s1; a2 += w * s2; }
#pragma unroll
                for (int i = 0; i < 4; ++i) { red[tid * 12 + i] = a0[i]; red[tid * 12 + 4 + i] = a1[i]; red[tid * 12 + 8 + i] = a2[i]; } }
            __syncthreads();
            if (tid < 72) { const int cond = tid / 24, c = tid % 24, q = c >> 2, e = c & 3; float sacc = 0.f;
                for (int ks = 0; ks < 85; ++ks) sacc += red[(ks * 6 + q) * 12 + cond * 4 + e];
                MOD[cond * 6144 + cb * 24 + c] = sacc + b_mod[cb * 24 + c]; }
            __syncthreads();
        }
        xcd_barrier_arrive(xbar);
        LAS float* scr = (LAS float*)(ldsl + wave * 16384);
        constexpr int I_IN = 16 * (DIN / 32), I_C = 16 * 32, I_Q = (QL / 64) * (1536 / 32), I_KV = (KVL / 64) * (2048 / 32), I_F1 = 16 * (2 * DFF / 32), I_F2 = (DFF / 64) * 32;
        for (int it = gw; it < I_IN; it += NGW) transpose_item(w_in, D, DIN, WIN, MAP_WIN, scr, it, lane);
        (void)I_C; (void)I_Q; (void)I_KV; (void)I_F1; (void)I_F2;
        for (int i = bx * 512 + tid; i < 64 * D / 8; i += G * 512) *(u32x4*)(WIN + (size_t)3776 * D + (size_t)i * 8) = (u32x4){0u, 0u, 0u, 0u};
    }
    xcd_barrier_wait(xbar);
    if (IN(1)) REP(1) {
#pragma unroll 2
        for (int row = gw; row < MT; row += NGW) {
            const float* src = row < M ? x + (size_t)row * D : ctx + (size_t)(row - M) * D;
            const float* md = MOD + (row < M ? (row >> 13) : 2) * 6144;
            norm_mod_row(src, norm_mix, md, md + D, XN + (size_t)row * D, lane);
        }
        xcd_barrier_arrive(xbar);
        CONV(0, CO_A);
        for (int t = gw; t < SEQ; t += NGW) {
            const int jj = lane & 31; const float fr = exp2f(-(float)(jj & 15) * (13.287712379549449f / 16.f)); const float pos = (float)((jj >> 4) ? (t & 63) : (t >> 6));
            float sn, cs; sincosf(pos * fr, &sn, &cs); ROPE[(size_t)t * 64 + lane] = lane < 32 ? cs : sn; }
    }
    xcd_barrier_wait(xbar);
    if (IN(2)) REP(2) {
        pg8::Gemm g{XN, WIN, MT, DINP, D}; pg8::StaticOrder S; S.init(MT, DINP, G, bx);
        Epi8<FIn> E{{BX, UU, QA, KVA, SGC, SGA, b_gate}};
        pg8::gemm_phase<Epi8<FIn>, pg8::StaticOrder, true, true>(ldsl, g, S, E);
    }
    SEAMW(CONV(CO_A, CO_F1));
    if (IN(3)) REP(3) {
        for (int row = gw; row < MT; row += NGW) {
            const int tl = row & (SEQ - 1); const bool lat = row < M;
            const size_t o0 = (size_t)row * D + lane * 8, o1 = o0 + 512; const u32x4 z4 = {0u, 0u, 0u, 0u};
            u32x4 lb0 = z4, lb1 = z4, lu0 = z4, lu1 = z4, lm0 = z4, lm1 = z4, lp0 = z4, lp1 = z4, lq = z4, lk = z4;
            if (lat) { lb0 = *(const u32x4*)(BX + o0); lb1 = *(const u32x4*)(BX + o1); lu0 = *(const u32x4*)(UU + o0); lu1 = *(const u32x4*)(UU + o1);
                if (tl > 0) { lm0 = *(const u32x4*)(UU + o0 - D); lm1 = *(const u32x4*)(UU + o1 - D); }
                if (tl < SEQ - 1) { lp0 = *(const u32x4*)(UU + o0 + D); lp1 = *(const u32x4*)(UU + o1 + D); }
                if (lane < 48) lq = *(const u32x4*)(QA + (size_t)row * QL + lane * 8); }
            if (lane < 32) lk = *(const u32x4*)(KVA + (size_t)row * 320 + lane * 8);
            const float kr = bf1(KVA[(size_t)row * 320 + 256 + lane]);
            float rc = 1.f, rs = 0.f; if (lat) { const float* rt = ROPE + (size_t)tl * 64 + (lane >> 5) * 16 + (lane & 15); rc = rt[0]; rs = rt[32]; }
            if (lat) {
#pragma unroll
                for (int j = 0; j < 2; ++j) { const int c = lane * 8 + 512 * j;
                    float bb[8], um[8], u0[8], up[8], r[8];
                    unpack8(j ? lb1 : lb0, bb); unpack8(j ? lu1 : lu0, u0); unpack8(j ? lm1 : lm0, um); unpack8(j ? lp1 : lp0, up);
#pragma unroll
                    for (int i = 0; i < 8; ++i) r[i] = bb[i] * (conv_w[c + i] * um[i] + conv_w[D + c + i] * u0[i] + conv_w[2 * D + c + i] * up[i] + conv_b[c + i]);
                    *(u32x4*)(U + (j ? o1 : o0)) = pack8(r); }
                float q[8]; float ss = 0.f; unpack8(lq, q);
#pragma unroll
                for (int i = 0; i < 8; ++i) ss += q[i] * q[i];
                const float rq = rsqrtf(wave_sum(ss) * (1.f / QL) + EPS);
                if (lane < 48) {
#pragma unroll
                    for (int i = 0; i < 8; ++i) q[i] = q[i] * rq * q_a_norm[lane * 8 + i];
                    *(u32x4*)(QAN + (size_t)row * QL + lane * 8) = pack8(q); }
            }
            { float q[8]; float ss = 0.f; unpack8(lk, q);
#pragma unroll
              for (int i = 0; i < 8; ++i) ss += q[i] * q[i];
              const float rk = rsqrtf(wave_sum(ss) * (1.f / KVL) + EPS);
              if (lane < 32) {
#pragma unroll
                  for (int i = 0; i < 8; ++i) q[i] = q[i] * rk * kv_a_norm[lane * 8 + i];
                  *(u32x4*)(KVAN + (size_t)row * KVL + lane * 8) = pack8(q); } }
            { const float krss = wave_sum(kr * kr); float w = kr * k_norm[128 + lane];
              if (lat) w = rope_apply(w, rc, rs, lane);
              KRB[(size_t)row * 64 + lane] = w; if (lane == 0) KRSS[row] = krss; }
        }
    }
    SEAMW(CONV(CO_F1, CO_F1 + CI_F1 / 2));
    if (IN(4)) REP(4) {
        if ((PH_MASK >> 12) & 1) { pg8::Gemm g{U, WC, M, D, D}; pg8::StaticOrder S; S.init(M, D, G, bx); Epi8<FConv> E{{SGC, Z}};
          pg8::gemm_phase<Epi8<FConv>, pg8::StaticOrder, true, true>(ldsl, g, S, E); }
        if ((PH_MASK >> 13) & 1) { int kq = QL; asm volatile("" : "+s"(kq)); pg8::Gemm g{QAN, WQ, M, 1536, kq}; pg8::StaticOrder S; S.init(M, 1536, G, bx); Epi8<FQ> E{{Qb}};
          pg8::gemm_phase<Epi8<FQ>, pg8::StaticOrder, true, true>(ldsl, g, S, E); }
        if ((PH_MASK >> 14) & 1) { int kkv = KVL; asm volatile("" : "+s"(kkv)); pg8::Gemm g{KVAN, WKV, MT, D, kkv}; pg8::StaticOrder S; S.init(MT, D, G, (bx + G / 2) % G); EpiK2 E{Kb, KRB, KRSS, k_norm, (LAS float*)(ldsl + 131072 + 1024)};
          pg8::gemm_phase<EpiK2, pg8::StaticOrder, true, true>(ldsl, g, S, E); }
        if ((PH_MASK >> 14) & 1) { int kkv = KVL; asm volatile("" : "+s"(kkv)); pg8::Gemm g{WKV + (size_t)D * KVL, KVAN, D, MT, kkv}; pg8::StaticOrder S; S.init(D, MT, G, (bx + G / 4) % G); Epi8<FVt> E{{Vtb}};
          pg8::gemm_phase<Epi8<FVt>, pg8::StaticOrder, true, true>(ldsl, g, S, E); }
    }
    SEAMW(CONV(CO_F1 + CI_F1 / 2, CO_F2));
    if (IN(6)) REP(6) {
        for (int L = vcu; L < 2 * NH * (SEQ / 256); L += G) {
            const int bh = L >> 5, qb = L & 31, b = bh >> 3, h = bh & 7;
            att::attn_unit(Qb + ((size_t)b * SEQ + qb * 256) * 1536 + h * DK, Kb + (size_t)bh * SKV * DK, Vtb + (size_t)bh * SKV * DV,
                           Ob + ((size_t)b * SEQ + qb * 256) * D + h * DV, (char*)lds, ldsl, q_norm, ROPE, qb * 256);
        }
    }
    SEAMW(CONV(CO_F2, CO_END));
    if (IN(7)) {
        pg8::Gemm g{Ob, WA, M, D, D}; pg8::StaticOrder S; S.init(M, D, G, bx); Epi8<FAo> E{{SGA, Z}};
        pg8::gemm_phase<Epi8<FAo>, pg8::StaticOrder, true, true>(ldsl, g, S, E);
    }
    xcd_barrier_arrive(xbar);
    {
        for (int n = gw; n < 2 * DFF; n += NGW) {
            float w0[8], w1[8]; unpack8(*(const u32x4*)(WF1 + (size_t)n * D + lane * 8), w0); unpack8(*(const u32x4*)(WF1 + (size_t)n * D + 512 + lane * 8), w1);
            const float* s0 = MOD + 3 * D + lane * 8; const float* s1 = s0 + 6144; float d0 = 0.f, d1 = 0.f;
#pragma unroll
            for (int i = 0; i < 8; ++i) { d0 += w0[i] * s0[i] + w1[i] * s0[512 + i]; d1 += w0[i] * s1[i] + w1[i] * s1[512 + i]; }
            d0 = wave_sum(d0); d1 = wave_sum(d1); if (lane == 0) { SHW[n] = d0; SHW[2 * DFF + n] = d1; } }
    }
    xcd_barrier_wait(xbar);
    if (IN(8)) {
        pg8::Gemm g{Z, WO, M, D, D}; pg8::StaticOrder S; S.init(M, D, G, bx); Epi8<FRes2> E{{x, args.out, MOD, norm_ffn, HX2, ROWSS}};
        pg8::gemm_phase<Epi8<FRes2>, pg8::StaticOrder, true, true>(ldsl, g, S, E);
    }
    SEAM2(8, 10);
    if (IN(10)) REP(10) {
        pg8::Gemm g{HX2, WF1, M, 2 * DFF, D}; pg8::StaticOrder S; S.init(M, 2 * DFF, G, bx); Epi8<FFfn1> E{{Hb, ROWSS, SHW}};
        pg8::gemm_phase<Epi8<FFfn1>, pg8::StaticOrder, true, true>(ldsl, g, S, E);
    }
    SEAM(10);
    if (IN(11)) {
        pg8::Gemm g{Hb, WF2, M, D, DFF}; pg8::StaticOrder S; S.init(M, D, G, bx); Epi8<FRes> E{{args.out, args.out, MOD + 5 * D}};
        pg8::gemm_phase<Epi8<FRes>, pg8::StaticOrder, true, true>(ldsl, g, S, E);
    }
#undef IN
#undef SEAM
#undef SEAM2
}

#ifndef MK_PER_PHASE
#define MK_PER_PHASE 0
#endif
extern "C" void kernel_launch(void* const* d_in, const int* in_sizes, int n_in, void* d_out, int out_size, void* d_ws, size_t ws_size, hipStream_t stream) {
    static int grid = 0;
    if (grid == 0) {
        if (n_in != 23 || out_size != M * D || ws_size < WS_END) { fprintf(stderr, "kernel_launch: unexpected shapes n_in %d out %d ws %zu (need %zu)\n", n_in, out_size, ws_size, (size_t)WS_END); grid = -1; return; }
        int dev = 0, cus = 0, per_cu = 0;
        hipGetDevice(&dev); hipDeviceGetAttribute(&cus, hipDeviceAttributeMultiprocessorCount, dev);
        if (hipFuncSetAttribute((const void*)mega_fwd, hipFuncAttributeMaxDynamicSharedMemorySize, LDS_BYTES) != hipSuccess) { fprintf(stderr, "kernel_launch: hipFuncSetAttribute failed\n"); grid = -1; return; }
        if (hipOccupancyMaxActiveBlocksPerMultiprocessor(&per_cu, (const void*)mega_fwd, 512, LDS_BYTES) != hipSuccess || per_cu < 1) { fprintf(stderr, "kernel_launch: occupancy query says %d\n", per_cu); (void)hipGetLastError(); grid = -1; return; }
        grid = cus * per_cu; if (grid > 256) grid = 256;
        fprintf(stderr, "kernel_launch: grid %d (cus %d x %d)\n", grid, cus, per_cu);
    }
    if (grid < 0) return;
    (void)hipMemsetAsync((char*)d_ws + WS_MOD, 0, CTL_BYTES, stream);
    Args a{};
    for (int i = 0; i < 23; ++i) a.in[i] = (const float*)d_in[i];
    a.out = (float*)d_out; a.ws = (unsigned char*)d_ws;
#if MK_PER_PHASE
    for (int p = 0; p < NPHASE; ++p) { a.lo = p; a.hi = p + 1; hipLaunchKernelGGL(mega_fwd, dim3(grid), dim3(512), LDS_BYTES, stream, a); }
#else
    a.lo = 0; a.hi = NPHASE;
    void* kargs[] = {&a};
    hipError_t e = hipLaunchCooperativeKernel((const void*)mega_fwd, dim3(grid), dim3(512), kargs, LDS_BYTES, stream);
    if (e != hipSuccess) fprintf(stderr, "kernel_launch: cooperative launch failed: %s (grid %d)\n", hipGetErrorString(e), grid);
#endif
}
```
